# Optimizing an MI355X kernel written in HIP

```python
import jax, jax.numpy as jnp
from jax import lax
import numpy as np

D_MODEL = 1024
BATCH = 1
SEQ = 16384
DEPTH = 2

N_HEADS = 16
HEAD_DIM = D_MODEL // N_HEADS
HD = N_HEADS * HEAD_DIM
D_FF = ((8 * D_MODEL + 3 * 256 - 1) // (3 * 256)) * 256
PLE_DIM = 256
BLOCK_Q = 128
N_A = DEPTH // 2
N_B = DEPTH - N_A
EPS = 1e-6

kernel_name = 'yoco_stickbreak_fox_hybrid'


def rms_norm(x, g):
    xf = x.astype(jnp.float32)
    y = xf * lax.rsqrt(jnp.mean(xf * xf, axis=-1, keepdims=True) + EPS)
    return (y * g.astype(jnp.float32)).astype(x.dtype)


def split_heads(t):
    b, s, _ = t.shape
    return t.reshape(b, s, N_HEADS, HEAD_DIM).transpose(0, 2, 1, 3)


def merge_heads(t):
    b, h, s, d = t.shape
    return t.transpose(0, 2, 1, 3).reshape(b, s, h * d)


def to_blocks(t):
    b, h, s = t.shape[:3]
    t = t.reshape((b, h, s // BLOCK_Q, BLOCK_Q) + t.shape[3:])
    return jnp.moveaxis(t, 2, 0)


def from_blocks(t):
    t = jnp.moveaxis(t, 0, 2)
    b, h, nb, bq, d = t.shape
    return t.reshape(b, h, nb * bq, d)


def stick_breaking_attention(q, k, v):
    s_len = q.shape[2]
    nb = s_len // BLOCK_Q
    kpos = jnp.arange(s_len)
    scale = HEAD_DIM ** -0.5

    def block(args):
        qb, i = args
        tpos = i * BLOCK_Q + jnp.arange(BLOCK_Q)
        z = jnp.einsum('bhqd,bhkd->bhqk', qb, k).astype(jnp.float32) * scale
        strict = kpos[None, :] < tpos[:, None]
        log_one_minus = jnp.where(strict, -jax.nn.softplus(z), 0.0)
        later = lax.cumsum(log_one_minus, axis=3, reverse=True) - log_one_minus
        w = jnp.where(strict, jnp.exp(jax.nn.log_sigmoid(z) + later), 0.0)
        return jnp.einsum('bhqk,bhkd->bhqd', w.astype(v.dtype), v)

    out = lax.map(block, (to_blocks(q), jnp.arange(nb)))
    return from_blocks(out)


def forgetting_attention(q, k, v, f_cum):
    s_len = q.shape[2]
    nb = s_len // BLOCK_Q
    kpos = jnp.arange(s_len)
    scale = HEAD_DIM ** -0.5

    def block(args):
        qb, fb, i = args
        tpos = i * BLOCK_Q + jnp.arange(BLOCK_Q)
        logits = (jnp.einsum('bhqd,bhkd->bhqk', qb, k).astype(jnp.float32) * scale
                  + fb[..., :, None] - f_cum[:, :, None, :])
        causal = kpos[None, :] <= tpos[:, None]
        logits = jnp.where(causal, logits, -jnp.inf)
        probs = jax.nn.softmax(logits, axis=-1)
        return jnp.einsum('bhqk,bhkd->bhqd', probs.astype(v.dtype), v)

    out = lax.map(block, (to_blocks(q), to_blocks(f_cum), jnp.arange(nb)))
    return from_blocks(out)


def swiglu(h, w_gu, w_d):
    g, u = jnp.split(h @ w_gu, 2, axis=-1)
    return (jax.nn.silu(g) * u) @ w_d


def setup_inputs(seed: int = 0) -> dict:
    key = jax.random.key(seed)
    ks = jax.random.split(key, 20)
    f32 = jnp.float32

    def w(k, shape, fan_in, extra=1.0):
        return jax.random.normal(k, shape, f32) * (fan_in ** -0.5) * extra

    def gain(k, shape):
        return 1.0 + 0.05 * jax.random.normal(k, shape, f32)

    res_scale = (2.0 * DEPTH) ** -0.5
    return {
        'x': jax.random.normal(ks[0], (BATCH, SEQ, D_MODEL), f32),
        'p': jax.random.normal(ks[1], (DEPTH, BATCH, SEQ, PLE_DIM), f32),
        'attn_norm_g': gain(ks[2], (DEPTH, D_MODEL)),
        'sb_w_qkv': w(ks[3], (N_A, D_MODEL, 3 * HD), D_MODEL),
        'sb_w_o': w(ks[4], (N_A, HD, D_MODEL), HD, res_scale),
        'shared_norm_g': gain(ks[5], (D_MODEL,)),
        'shared_w_kvf': w(ks[6], (D_MODEL, 2 * HD + N_HEADS), D_MODEL),
        'shared_b_f': 0.1 * jax.random.normal(ks[7], (N_HEADS,), f32),
        'shared_k_norm_g': gain(ks[8], (HEAD_DIM,)),
        'fox_w_q': w(ks[9], (N_B, D_MODEL, HD), D_MODEL),
        'fox_q_norm_g': gain(ks[10], (N_B, HEAD_DIM)),
        'fox_w_o': w(ks[11], (N_B, HD, D_MODEL), HD, res_scale),
        'ffn_norm_g': gain(ks[12], (DEPTH, D_MODEL)),
        'ffn_w_gu': w(ks[13], (DEPTH, D_MODEL, 2 * D_FF), D_MODEL),
        'ffn_w_d': w(ks[14], (DEPTH, D_FF, D_MODEL), D_FF, res_scale),
        'ple_norm_g': gain(ks[15], (DEPTH, D_MODEL)),
        'ple_w_gate': w(ks[16], (DEPTH, D_MODEL, D_MODEL), D_MODEL),
        'ple_w_proj': w(ks[17], (DEPTH, PLE_DIM, D_MODEL), PLE_DIM, res_scale),
    }


def reference(x, p, attn_norm_g, sb_w_qkv, sb_w_o, shared_norm_g, shared_w_kvf, shared_b_f,
              shared_k_norm_g, fox_w_q, fox_q_norm_g, fox_w_o, ffn_norm_g, ffn_w_gu, ffn_w_d,
              ple_norm_g, ple_w_gate, ple_w_proj):
    h = x
    k_sh = v_sh = f_cum = None
    for i in range(DEPTH):
        hn = rms_norm(h, attn_norm_g[i])
        if i < N_A:
            q, k, v = jnp.split(hn @ sb_w_qkv[i], 3, axis=-1)
            mix = stick_breaking_attention(split_heads(q), split_heads(k), split_heads(v))
            h = h + merge_heads(mix) @ sb_w_o[i]
        else:
            if i == N_A:
                hs = rms_norm(h, shared_norm_g)
                kvf = hs @ shared_w_kvf
                k_sh = rms_norm(split_heads(kvf[..., :HD]), shared_k_norm_g)
                v_sh = split_heads(kvf[..., HD:2 * HD])
                f_logit = kvf[..., 2 * HD:].astype(jnp.float32) + shared_b_f.astype(jnp.float32)
                f_cum = lax.cumsum(jax.nn.log_sigmoid(f_logit), axis=1).transpose(0, 2, 1)
            j = i - N_A
            q = rms_norm(split_heads(hn @ fox_w_q[j]), fox_q_norm_g[j])
            mix = forgetting_attention(q, k_sh, v_sh, f_cum)
            h = h + merge_heads(mix) @ fox_w_o[j]
        h = h + swiglu(rms_norm(h, ffn_norm_g[i]), ffn_w_gu[i], ffn_w_d[i])
        gate = jax.nn.sigmoid(rms_norm(h, ple_norm_g[i]) @ ple_w_gate[i])
        h = h + gate * (p[i] @ ple_w_proj[i])
    return h
```

```cpp
#include <hip/hip_runtime.h>
#include <hip/hip_cooperative_groups.h>
#include <cstdio>
#include <cstdint>
namespace cg = cooperative_groups;
namespace pg8 {
#define PG8_LAS __attribute__((address_space(3)))
typedef unsigned short bf16_t;
typedef short bf16x8 __attribute__((ext_vector_type(8)));
typedef float f32x4 __attribute__((ext_vector_type(4)));
typedef unsigned u32x4 __attribute__((ext_vector_type(4)));
constexpr int BM = 256, BK = 64, HALF = 128, HTB = HALF * BK * 2  , STAGE_BYTES = 8 * HTB, NXCD = 8, WGM = 8;

__host__ __device__ __forceinline__ int lds_byte(int r, int c) { const int st = (r >> 4) * 2 + (c >> 5), rr = r & 15, cc = c & 31, ob = rr * 64 + cc * 2; return st * 1024 + (ob ^ (((ob >> 9) & 1) << 5)); }
__host__ __device__ __forceinline__ void stage_rc(int b, int& R, int& C) { const int st = b / 1024, sb = b % 1024, swz = sb ^ (((sb >> 9) & 1) << 5); R = (st >> 1) * 16 + swz / 64; C = (st & 1) * 32 + (swz % 64) / 2; }
__host__ __device__ __forceinline__ int perm32(int rho) { const int n = rho >> 4, i = rho & 15; return 8 * (i >> 2) + 4 * n + (i & 3); }

struct Unit { int pm, pn; };
struct Gemm { const bf16_t* A; const bf16_t* Bt; int M, N, K; };

struct StaticOrder {
    int nM, nN, nwg, G, c;
    __host__ __device__ void init(int M, int N, int G_, int c_) { nM = M / BM; nN = N / BM; nwg = nM * nN; G = G_; c = c_; }
    __host__ __device__ bool next(int i, Unit& u) const {
        const long L = (long)i * G + c; if (L >= nwg) return false;
        int wgid = (int)L; { const int q = nwg / NXCD, r = nwg % NXCD, xcd = wgid % NXCD, off = wgid / NXCD; wgid = (xcd < r ? xcd * (q + 1) : r * (q + 1) + (xcd - r) * q) + off; }
        const int nig = WGM * nN, gid = wgid / nig, fm = gid * WGM, gsz = (nM - fm) < WGM ? (nM - fm) : WGM;
        u.pm = fm + ((wgid % nig) % gsz); u.pn = (wgid % nig) / gsz; return true;
    }
    __device__ __forceinline__ void a_ready(const Unit&) const {}
    __device__ __forceinline__ void done(const Unit&) const {}
};


typedef unsigned u32x2 __attribute__((ext_vector_type(2)));
__device__ __forceinline__ unsigned cvt_pk_bf16(float lo, float hi) { unsigned r; asm volatile("v_cvt_pk_bf16_f32 %0, %1, %2" : "=v"(r) : "v"(lo), "v"(hi)); return r; }
constexpr float RMS_EPS = 1e-6f, LOG2E = 1.4426950408889634f;
__device__ __forceinline__ float row_rinv(const float* ssq, int row) { const f32x4 s = *(const f32x4*)(ssq + (size_t)row * 4); return rsqrtf(((s[0] + s[1]) + (s[2] + s[3])) * (1.0f / 1024.0f) + RMS_EPS); }
__device__ __forceinline__ float sigmoid_f(float a) { return __builtin_amdgcn_rcpf(1.0f + __builtin_amdgcn_exp2f(-a * LOG2E)); }

struct EpiQKV0 {
    static constexpr bool PERM = true, AFTER_DRAIN = false;
    bf16_t* O; size_t tstride; const float* ssq; float qscale;
    __device__ __forceinline__ void operator()(const f32x4 (&acc)[2][2][4][2], const Unit& u, int wr, int wc, int fr, int fq) const {
        const int row0 = u.pm * BM + wr * 64 + fr; const int t = u.pn >> 2; bf16_t* base = O + (size_t)t * tstride;
        const float sc = (t == 0) ? qscale : 1.f; const int col0 = (u.pn & 3) * 256 + wc * 32 + 8 * fq;
#pragma unroll
        for (int ai = 0; ai < 2; ++ai)
#pragma unroll
            for (int m = 0; m < 4; ++m) { const int row = row0 + ai * HALF + m * 16; const float r = row_rinv(ssq, row) * sc; bf16_t* rowp = base + (size_t)row * 1024 + col0;
#pragma unroll
                for (int bj = 0; bj < 2; ++bj) { const f32x4 v0 = acc[ai][bj][m][0] * r, v1 = acc[ai][bj][m][1] * r;
                    u32x4 w; w.x = cvt_pk_bf16(v0[0], v0[1]); w.y = cvt_pk_bf16(v0[2], v0[3]); w.z = cvt_pk_bf16(v1[0], v1[1]); w.w = cvt_pk_bf16(v1[2], v1[3]);
                    *(u32x4*)(rowp + bj * HALF) = w; } }
    }
};
struct EpiKVQ1 {
    static constexpr bool PERM = true, AFTER_DRAIN = false;
    bf16_t* O; size_t tstride; const float* ssq; const float* gk; const float* gq; float qscale;
    __device__ __forceinline__ void operator()(const f32x4 (&acc)[2][2][4][2], const Unit& u, int wr, int wc, int fr, int fq) const {
        const int row0 = u.pm * BM + wr * 64 + fr; const int t = u.pn >> 2; bf16_t* base = O + (size_t)((t + 1) % 3) * tstride;
        const int head = (u.pn & 3) * 4 + wc;
        f32x4 gv[2][2];
        if (t != 1) { const float* g = (t == 0) ? gk : gq; const float s = (t == 0) ? 1.f : qscale;
#pragma unroll
            for (int bj = 0; bj < 2; ++bj)
#pragma unroll
                for (int n = 0; n < 2; ++n) gv[bj][n] = *(const f32x4*)(g + 32 * bj + 8 * fq + 4 * n) * s; }
#pragma unroll
        for (int ai = 0; ai < 2; ++ai)
#pragma unroll
            for (int m = 0; m < 4; ++m) { const int row = row0 + ai * HALF + m * 16; const float r = row_rinv(ssq, row);
                f32x4 v[2][2];
#pragma unroll
                for (int bj = 0; bj < 2; ++bj)
#pragma unroll
                    for (int n = 0; n < 2; ++n) v[bj][n] = acc[ai][bj][m][n] * r;
                if (t != 1) { float ss = 0.f;
#pragma unroll
                    for (int bj = 0; bj < 2; ++bj)
#pragma unroll
                        for (int n = 0; n < 2; ++n) { const f32x4 x = v[bj][n]; ss += (x[0] * x[0] + x[1] * x[1]) + (x[2] * x[2] + x[3] * x[3]); }
                    ss += __shfl_xor(ss, 16); ss += __shfl_xor(ss, 32);
                    const float rn = rsqrtf(ss * (1.0f / 64.0f) + RMS_EPS);
#pragma unroll
                    for (int bj = 0; bj < 2; ++bj)
#pragma unroll
                        for (int n = 0; n < 2; ++n) v[bj][n] = v[bj][n] * rn * gv[bj][n]; }
                bf16_t* rowp = base + (size_t)row * 1024 + head * 64 + 8 * fq;
#pragma unroll
                for (int bj = 0; bj < 2; ++bj) { const f32x4 v0 = v[bj][0], v1 = v[bj][1];
                    u32x4 w; w.x = cvt_pk_bf16(v0[0], v0[1]); w.y = cvt_pk_bf16(v0[2], v0[3]); w.z = cvt_pk_bf16(v1[0], v1[1]); w.w = cvt_pk_bf16(v1[2], v1[3]);
                    *(u32x4*)(rowp + 32 * bj) = w; } }
    }
};
struct EpiGU {
    static constexpr bool PERM = true, AFTER_DRAIN = false;
    bf16_t* O; const float* ssq;
    __device__ __forceinline__ void operator()(const f32x4 (&acc)[2][2][4][2], const Unit& u, int wr, int wc, int fr, int fq) const {
        const int row0 = u.pm * BM + wr * 64 + fr; const int col0 = u.pn * 128 + wc * 32 + 8 * fq;
#pragma unroll
        for (int ai = 0; ai < 2; ++ai)
#pragma unroll
            for (int m = 0; m < 4; ++m) { const int row = row0 + ai * HALF + m * 16; const float r = row_rinv(ssq, row); bf16_t* rowp = O + (size_t)row * 2816 + col0;
                f32x4 a[2];
#pragma unroll
                for (int n = 0; n < 2; ++n) { const f32x4 g = acc[ai][0][m][n] * r, uu = acc[ai][1][m][n] * r;
#pragma unroll
                    for (int i = 0; i < 4; ++i) a[n][i] = g[i] * sigmoid_f(g[i]) * uu[i]; }
                u32x4 w; w.x = cvt_pk_bf16(a[0][0], a[0][1]); w.y = cvt_pk_bf16(a[0][2], a[0][3]); w.z = cvt_pk_bf16(a[1][0], a[1][1]); w.w = cvt_pk_bf16(a[1][2], a[1][3]);
                *(u32x4*)rowp = w; }
    }
};
struct EpiProj {
    static constexpr bool PERM = false, AFTER_DRAIN = false;
    bf16_t* O;
    __device__ __forceinline__ void operator()(const f32x4 (&acc)[2][2][4][2], const Unit& u, int wr, int wc, int fr, int fq) const {
        const int row0 = u.pm * BM + wr * 64 + fr; const int col0 = u.pn * BM + wc * 32 + 4 * fq;
#pragma unroll
        for (int ai = 0; ai < 2; ++ai)
#pragma unroll
            for (int m = 0; m < 4; ++m) { bf16_t* rowp = O + (size_t)(row0 + ai * HALF + m * 16) * 1024 + col0;
#pragma unroll
                for (int bj = 0; bj < 2; ++bj)
#pragma unroll
                    for (int n = 0; n < 2; ++n) { const f32x4 v = acc[ai][bj][m][n]; u32x2 w; w.x = cvt_pk_bf16(v[0], v[1]); w.y = cvt_pk_bf16(v[2], v[3]); *(u32x2*)(rowp + bj * HALF + n * 16) = w; } }
    }
};
struct EpiRes {
    static constexpr bool PERM = false, AFTER_DRAIN = true;
    const float* base; float* out; bf16_t* hb; float* ssq_out;
    __device__ __forceinline__ void fused(const f32x4 (&acc)[2][2][4][2], const Unit& u, int wr, int wc, int fr, int fq, PG8_LAS unsigned char* lds, int wid, int lane) const {
        PG8_LAS float* P = (PG8_LAS float*)lds;
        const int col0 = u.pn * BM + wc * 32 + 4 * fq;
#pragma unroll
        for (int ai = 0; ai < 2; ++ai)
#pragma unroll
            for (int m = 0; m < 4; ++m) { const int r = ai * HALF + wr * 64 + m * 16 + fr; const size_t off = (size_t)(u.pm * BM + r) * 1024 + col0; float s = 0.f;
#pragma unroll
                for (int bj = 0; bj < 2; ++bj)
#pragma unroll
                    for (int n = 0; n < 2; ++n) { const f32x4 bs = *(const f32x4*)(base + off + bj * HALF + n * 16); const f32x4 v = bs + acc[ai][bj][m][n];
                        *(f32x4*)(out + off + bj * HALF + n * 16) = v; u32x2 w; w.x = cvt_pk_bf16(v[0], v[1]); w.y = cvt_pk_bf16(v[2], v[3]); *(u32x2*)(hb + off + bj * HALF + n * 16) = w;
                        s += (v[0] * v[0] + v[1] * v[1]) + (v[2] * v[2] + v[3] * v[3]); }
                s += __shfl_xor(s, 16); s += __shfl_xor(s, 32);
                if (fq == 0) P[r * 4 + wc] = s;
                if (m & 1) asm volatile("" ::: "memory"); }
        asm volatile("s_waitcnt lgkmcnt(0)" ::: "memory"); __builtin_amdgcn_s_barrier(); asm volatile("" ::: "memory");
        const int tid = wid * 64 + lane;
        if (tid < 256) { const f32x4 p = *(const PG8_LAS f32x4*)(P + tid * 4); ssq_out[(size_t)(u.pm * BM + tid) * 4 + u.pn] = (p[0] + p[1]) + (p[2] + p[3]); }
        asm volatile("s_waitcnt lgkmcnt(0)" ::: "memory"); __builtin_amdgcn_s_barrier(); asm volatile("" ::: "memory");
    }
};
struct EpiPle {
    static constexpr bool PERM = false, AFTER_DRAIN = true;
    const float* ssq_in; const bf16_t* projp; float* io; bf16_t* hb; float* ssq_out;
    __device__ __forceinline__ void fused(const f32x4 (&acc)[2][2][4][2], const Unit& u, int wr, int wc, int fr, int fq, PG8_LAS unsigned char* lds, int wid, int lane) const {
        PG8_LAS float* P = (PG8_LAS float*)lds;
        const int col0 = u.pn * BM + wc * 32 + 4 * fq;
#pragma unroll
        for (int ai = 0; ai < 2; ++ai)
#pragma unroll
            for (int m = 0; m < 4; ++m) { const int r = ai * HALF + wr * 64 + m * 16 + fr; const int row = u.pm * BM + r; const size_t off = (size_t)row * 1024 + col0; float s = 0.f;
                const float ri = row_rinv(ssq_in, row);
#pragma unroll
                for (int bj = 0; bj < 2; ++bj)
#pragma unroll
                    for (int n = 0; n < 2; ++n) { const size_t o2 = off + bj * HALF + n * 16; const f32x4 bs = *(const f32x4*)(io + o2); const u32x2 pw = *(const u32x2*)(projp + o2);
                        const f32x4 a = acc[ai][bj][m][n] * ri; f32x4 v;
                        v[0] = bs[0] + sigmoid_f(a[0]) * __uint_as_float(pw.x << 16); v[1] = bs[1] + sigmoid_f(a[1]) * __uint_as_float(pw.x & 0xffff0000u);
                        v[2] = bs[2] + sigmoid_f(a[2]) * __uint_as_float(pw.y << 16); v[3] = bs[3] + sigmoid_f(a[3]) * __uint_as_float(pw.y & 0xffff0000u);
                        *(f32x4*)(io + o2) = v;
                        if (hb) { u32x2 w; w.x = cvt_pk_bf16(v[0], v[1]); w.y = cvt_pk_bf16(v[2], v[3]); *(u32x2*)(hb + o2) = w; }
                        s += (v[0] * v[0] + v[1] * v[1]) + (v[2] * v[2] + v[3] * v[3]); }
                s += __shfl_xor(s, 16); s += __shfl_xor(s, 32);
                if (fq == 0) P[r * 4 + wc] = s;
                if (m & 1) asm volatile("" ::: "memory"); }
        asm volatile("s_waitcnt lgkmcnt(0)" ::: "memory"); __builtin_amdgcn_s_barrier(); asm volatile("" ::: "memory");
        const int tid = wid * 64 + lane;
        if (ssq_out && tid < 256) { const f32x4 p = *(const PG8_LAS f32x4*)(P + tid * 4); ssq_out[(size_t)(u.pm * BM + tid) * 4 + u.pn] = (p[0] + p[1]) + (p[2] + p[3]); }
        asm volatile("s_waitcnt lgkmcnt(0)" ::: "memory"); __builtin_amdgcn_s_barrier(); asm volatile("" ::: "memory");
    }
};
struct OneUnit {
    Unit u;
    __device__ __forceinline__ bool next(int i, Unit& o) const { if (i) return false; o = u; return true; }
    __device__ __forceinline__ void a_ready(const Unit&) const {}
    __device__ __forceinline__ void done(const Unit&) const {}
};

template <class Epi, class Sched, bool ALIGN_EPI = false, bool SP2 = false>
__device__ __forceinline__ void gemm_phase(PG8_LAS unsigned char* lds, const Gemm g, const Sched& S, const Epi& E) {
    int tid_ = threadIdx.x; asm volatile("" : "+v"(tid_));
    const int tid = tid_, wid = __builtin_amdgcn_readfirstlane(tid >> 6), lane = tid & 63, wr = wid >> 2, wc = wid & 3, fr = lane & 15, fq = lane >> 4;
    const int K = g.K, nt = K / BK;
    unsigned voffA[2], voffB[2];
#pragma unroll
    for (int i = 0; i < 2; ++i) { int R, C; stage_rc(tid * 16 + i * 8192, R, C); const int Rb = Epi::PERM ? ((R & ~31) + perm32(R & 31)) : R;
        voffA[i] = (unsigned)(R * K + C) * 2u; voffB[i] = (unsigned)(Rb * K + C) * 2u; }
    const size_t kstep = (size_t)(BK * 2);
    const size_t hstep = (size_t)HALF * K * 2;
    const size_t tstep = 2 * hstep;
    const unsigned ldsw = (unsigned)wid * 1024u;
    const int aoff = lds_byte(wr * 64 + fr, fq * 8), boff = lds_byte(wc * 32 + fr, fq * 8);
#define PG8_SA(b, h) (((b) * 2 + (h)) * HTB)
#define PG8_SB(b, h) ((4 + (b) * 2 + (h)) * HTB)
#define PG8_STAGE(bufoff, gbase, voff) do { _Pragma("unroll") for (int _i = 0; _i < 2; ++_i) \
        __builtin_amdgcn_global_load_lds((const unsigned*)((const char*)(gbase) + (voff)[_i]), (PG8_LAS unsigned*)(lds + (bufoff) + ldsw + _i * 8192), 16, 0, 0); } while (0)
#define PG8_LDA(dst, b, h) do { _Pragma("unroll") for (int m = 0; m < 4; ++m) _Pragma("unroll") for (int k = 0; k < 2; ++k) dst[m][k] = *(const PG8_LAS bf16x8*)(lds + PG8_SA(b, h) + aoff + m * 2048 + k * 1024); } while (0)
#define PG8_LDB(dst, b, h) do { _Pragma("unroll") for (int n = 0; n < 2; ++n) _Pragma("unroll") for (int k = 0; k < 2; ++k) dst[n][k] = *(const PG8_LAS bf16x8*)(lds + PG8_SB(b, h) + boff + n * 2048 + k * 1024); } while (0)
#define PG8_MMA(ai, bj, At, Bt) do { __builtin_amdgcn_s_setprio(1); _Pragma("unroll") for (int m = 0; m < 4; ++m) _Pragma("unroll") for (int n = 0; n < 2; ++n) _Pragma("unroll") for (int k = 0; k < 2; ++k) \
        acc[ai][bj][m][n] = __builtin_amdgcn_mfma_f32_16x16x32_bf16(Bt[n][k], At[m][k], acc[ai][bj][m][n], 0, 0, 0); __builtin_amdgcn_s_setprio(0); } while (0)
#define PG8_WAIT_V(n) asm volatile("s_waitcnt vmcnt(" #n ")" ::: "memory")
#define PG8_WAIT_L(n) asm volatile("s_waitcnt lgkmcnt(" #n ")" ::: "memory")
#define PG8_BAR __builtin_amdgcn_s_barrier()
#define PG8_SCHED __builtin_amdgcn_sched_barrier(0)
    Unit cur, nxt; int ui = 0;
    if (!S.next(0, cur)) return;
    f32x4 acc[2][2][4][2];
#pragma unroll
    for (int a = 0; a < 2; ++a)
#pragma unroll
        for (int b = 0; b < 2; ++b)
#pragma unroll
            for (int m = 0; m < 4; ++m)
#pragma unroll
                for (int n = 0; n < 2; ++n) acc[a][b][m][n] = (f32x4){0.f, 0.f, 0.f, 0.f};
    bf16x8 At[4][2], B0[2][2], B1[2][2];
    const char* cA = (const char*)g.A + (size_t)cur.pm * tstep; const char* cB = (const char*)g.Bt + (size_t)cur.pn * tstep;
    S.a_ready(cur);
    if constexpr (SP2) {
        PG8_STAGE(PG8_SB(0, 0), cB, voffB); PG8_STAGE(PG8_SB(0, 1), cB + hstep, voffB); PG8_STAGE(PG8_SA(0, 0), cA, voffA); PG8_STAGE(PG8_SA(0, 1), cA + hstep, voffA);
        if (wr == 1) PG8_BAR;
        PG8_WAIT_V(2); PG8_BAR;
        PG8_STAGE(PG8_SB(1, 0), cB + kstep, voffB); PG8_STAGE(PG8_SA(1, 0), cA + kstep, voffA); PG8_STAGE(PG8_SB(1, 1), cB + hstep + kstep, voffB);
        PG8_WAIT_V(6); PG8_BAR;
    } else {
        PG8_STAGE(PG8_SB(0, 0), cB, voffB); PG8_STAGE(PG8_SA(0, 0), cA, voffA); PG8_STAGE(PG8_SB(0, 1), cB + hstep, voffB); PG8_STAGE(PG8_SA(0, 1), cA + hstep, voffA);
        if (wr == 1) PG8_BAR;
        PG8_WAIT_V(4); PG8_BAR;
        PG8_STAGE(PG8_SB(1, 0), cB + kstep, voffB); PG8_STAGE(PG8_SA(1, 0), cA + kstep, voffA); PG8_STAGE(PG8_SB(1, 1), cB + hstep + kstep, voffB);
        PG8_WAIT_V(6); PG8_BAR;
    }
    for (;;) {
        const bool has_next = S.next(ui + 1, nxt);
        const char* nA = has_next ? (const char*)g.A + (size_t)nxt.pm * tstep : cA; const char* nB = has_next ? (const char*)g.Bt + (size_t)nxt.pn * tstep : cB;
        for (int t = 0; t < nt; t += 2) {
            const bool last = (t == nt - 2);
            const char* a1 = cA + (size_t)(t + 1) * kstep;
            const char* a2 = last ? nA : cA + (size_t)(t + 2) * kstep; const char* b2 = last ? nB : cB + (size_t)(t + 2) * kstep;
            const char* a3 = a2 + kstep; const char* b3 = b2 + kstep;
            if (last && has_next) S.a_ready(nxt);
            if constexpr (SP2) {
            PG8_LDB(B0, 0, 0); PG8_LDB(B1, 0, 1); PG8_SCHED; PG8_LDA(At, 0, 0); PG8_STAGE(PG8_SA(1, 1), a1 + hstep, voffA);
            PG8_WAIT_V(8); PG8_WAIT_L(0); PG8_BAR; PG8_MMA(0, 0, At, B0); PG8_MMA(0, 1, At, B1); PG8_BAR; PG8_SCHED;
            PG8_LDA(At, 0, 1); PG8_STAGE(PG8_SB(0, 0), b2, voffB); PG8_STAGE(PG8_SB(0, 1), b2 + hstep, voffB); PG8_STAGE(PG8_SA(0, 0), a2, voffA);
            PG8_WAIT_V(8); PG8_WAIT_L(0); PG8_BAR; PG8_MMA(1, 0, At, B0); PG8_MMA(1, 1, At, B1); PG8_BAR; PG8_SCHED;
            PG8_LDB(B0, 1, 0); PG8_LDB(B1, 1, 1); PG8_SCHED; PG8_LDA(At, 1, 0); PG8_STAGE(PG8_SA(0, 1), a2 + hstep, voffA);
            PG8_WAIT_V(8); PG8_WAIT_L(0); PG8_BAR; PG8_MMA(0, 0, At, B0); PG8_MMA(0, 1, At, B1); PG8_BAR; PG8_SCHED;
            PG8_LDA(At, 1, 1); PG8_STAGE(PG8_SB(1, 0), b3, voffB); PG8_STAGE(PG8_SB(1, 1), b3 + hstep, voffB); PG8_STAGE(PG8_SA(1, 0), a3, voffA);
            PG8_WAIT_V(8); PG8_WAIT_L(0); PG8_BAR; PG8_MMA(1, 0, At, B0); PG8_MMA(1, 1, At, B1); PG8_BAR; PG8_SCHED;
            } else {
            PG8_LDB(B0, 0, 0); PG8_SCHED; PG8_LDA(At, 0, 0); PG8_STAGE(PG8_SA(1, 1), a1 + hstep, voffA);
            PG8_WAIT_L(8); PG8_BAR; PG8_WAIT_L(0); PG8_MMA(0, 0, At, B0); PG8_BAR; PG8_SCHED;
            PG8_LDB(B1, 0, 1); PG8_STAGE(PG8_SB(0, 0), b2, voffB);
            PG8_BAR; PG8_WAIT_L(0); PG8_MMA(0, 1, At, B1); PG8_BAR;
            PG8_LDA(At, 0, 1); PG8_STAGE(PG8_SA(0, 0), a2, voffA);
            PG8_BAR; PG8_WAIT_L(0); PG8_MMA(1, 0, At, B0); PG8_BAR; PG8_SCHED;
            PG8_STAGE(PG8_SB(0, 1), b2 + hstep, voffB);
            PG8_WAIT_V(6); PG8_BAR; PG8_MMA(1, 1, At, B1); PG8_BAR;
            PG8_LDB(B0, 1, 0); PG8_SCHED; PG8_LDA(At, 1, 0); PG8_STAGE(PG8_SA(0, 1), a2 + hstep, voffA);
            PG8_WAIT_L(8); PG8_BAR; PG8_WAIT_L(0); PG8_MMA(0, 0, At, B0); PG8_BAR; PG8_SCHED;
            PG8_LDB(B1, 1, 1); PG8_STAGE(PG8_SB(1, 0), b3, voffB);
            PG8_BAR; PG8_WAIT_L(0); PG8_MMA(0, 1, At, B1); PG8_BAR;
            PG8_LDA(At, 1, 1); PG8_STAGE(PG8_SA(1, 0), a3, voffA);
            PG8_BAR; PG8_WAIT_L(0); PG8_MMA(1, 0, At, B0); PG8_BAR; PG8_SCHED;
            PG8_STAGE(PG8_SB(1, 1), b3 + hstep, voffB);
            PG8_WAIT_V(6); PG8_BAR; PG8_MMA(1, 1, At, B1); PG8_BAR;
            }
        }
        if constexpr (ALIGN_EPI) { if (wr == 0) PG8_BAR; }
        if constexpr (!Epi::AFTER_DRAIN) { E(acc, cur, wr, wc, fr, fq); S.done(cur); }
        if (!has_next) break;
#pragma unroll
        for (int a = 0; a < 2; ++a)
#pragma unroll
            for (int b = 0; b < 2; ++b)
#pragma unroll
                for (int m = 0; m < 4; ++m)
#pragma unroll
                    for (int n = 0; n < 2; ++n) acc[a][b][m][n] = (f32x4){0.f, 0.f, 0.f, 0.f};
        cur = nxt; cA = nA; cB = nB; ++ui;
        if constexpr (ALIGN_EPI) { if (wr == 1) PG8_BAR; }
    }
    PG8_WAIT_V(0);
    if constexpr (!ALIGN_EPI) { if (wr == 0) PG8_BAR; }
    PG8_BAR;
    if constexpr (Epi::AFTER_DRAIN) { E.fused(acc, cur, wr, wc, fr, fq, lds, wid, lane); S.done(cur); }
#undef PG8_SA
#undef PG8_SB
#undef PG8_STAGE
#undef PG8_LDA
#undef PG8_LDB
#undef PG8_MMA
#undef PG8_WAIT_V
#undef PG8_WAIT_L
#undef PG8_BAR
#undef PG8_SCHED
}
}

constexpr int M = 16384, D = 1024, NH = 16, DH = 64, FF = 2816, PLE = 256;
constexpr float LOG2E_F = 1.4426950408889634f;
constexpr float QSCALE = 0.125f * LOG2E_F;
constexpr float THR2 = 160.0f;
constexpr int NWAVES = 8;

#define GAS __attribute__((address_space(1)))
#define LAS __attribute__((address_space(3)))
typedef unsigned short bf16;
typedef unsigned v4u __attribute__((ext_vector_type(4)));
typedef unsigned v2u __attribute__((ext_vector_type(2)));
typedef float f32x4 __attribute__((ext_vector_type(4)));
typedef float f32x16 __attribute__((ext_vector_type(16)));
typedef short bf16x8 __attribute__((ext_vector_type(8)));
typedef short s16x4 __attribute__((ext_vector_type(4)));
#define RLX_AGENT __ATOMIC_RELAXED, __HIP_MEMORY_SCOPE_AGENT
#define LDS_WAIT() asm volatile("s_waitcnt lgkmcnt(0)" ::: "memory")
__device__ __forceinline__ unsigned f2bf(float f) { unsigned u = __builtin_bit_cast(unsigned, f); return (u + 0x7fffu + ((u >> 16) & 1u)) >> 16; }
__device__ __forceinline__ unsigned pk2(float lo, float hi) { return f2bf(lo) | (f2bf(hi) << 16); }
__device__ __forceinline__ unsigned cvtpk(float lo, float hi) { unsigned r; asm volatile("v_cvt_pk_bf16_f32 %0, %1, %2" : "=v"(r) : "v"(lo), "v"(hi)); return r; }
__device__ __forceinline__ float ex2(float x) { return __builtin_amdgcn_exp2f(x); }
__device__ __forceinline__ float lg2(float x) { return __builtin_amdgcn_logf(x); }

constexpr size_t MiB = 1u << 20;
constexpr size_t WS_CTL = 0, CTL_ZERO_BYTES = 64 * 1024;
constexpr size_t WS_SSQ = 1 * MiB;
constexpr size_t WS_WF = 1 * MiB + 6 * 256 * 1024;
constexpr size_t WS_LS2 = 3 * MiB;
constexpr size_t WS_WQKV0 = 4 * MiB, WS_WO0 = 10 * MiB, WS_WKVQ1 = 12 * MiB, WS_WO1 = 18 * MiB, WS_WGU = 20 * MiB  , WS_WD = 42 * MiB  , WS_WG = 53 * MiB  , WS_WP = 57 * MiB  ;
constexpr size_t WS_HBA = 58 * MiB, WS_HBB = 90 * MiB, WS_Q = 122 * MiB, WS_K = 154 * MiB, WS_V = 186 * MiB, WS_ACT = 122 * MiB  , WS_PBUF = 210 * MiB  , WS_PROJ = 218 * MiB, WS_END = 250 * MiB;
constexpr int CW_BAR = 1024;

constexpr int RING_BYTES = 131072, MISC_OFF = RING_BYTES + 320, LDS_BYTES = 147456;

#define XB_TMO      128
#define XB_XCNT(j)  (256  + 64 * (j))
#define XB_XSUB(j)  (1280 + 64 * (j))
#define XB_XGEN(j)  (2304 + 64 * (j))
#define XB_TOP      3328
#define XB_TOPGEN   3392
#define XCD_BAR_WORDS 3456
#define XB_SPIN_CAP (1u << 18)

__device__ __forceinline__ unsigned xb_ld(unsigned* p)              { return __hip_atomic_load(p, __ATOMIC_RELAXED, __HIP_MEMORY_SCOPE_AGENT); }
__device__ __forceinline__ unsigned xb_add(unsigned* p, unsigned v) { return __hip_atomic_fetch_add(p, v, __ATOMIC_RELAXED, __HIP_MEMORY_SCOPE_AGENT); }
__device__ __forceinline__ unsigned xb_xcc_id() { return (unsigned)__builtin_amdgcn_s_getreg((3 << 11) | 20) & 0xFu; }
#define XB_SPIN(cond, bar) do { unsigned _sp = 0; while (cond) { __builtin_amdgcn_s_sleep(1); \
    if ((++_sp & 255u) == 0u) { if (xb_ld(&(bar)[XB_TMO])) break; if (_sp > XB_SPIN_CAP) { atomicAdd(&(bar)[XB_TMO], 1u); break; } } } } while (0)

struct XcdBarrier {
    unsigned* bar; unsigned x;
    volatile LAS unsigned* st;
};

__device__ __forceinline__ XcdBarrier xcd_barrier_post(unsigned* bar, volatile LAS unsigned* st) {
    XcdBarrier b; b.bar = bar; b.x = xb_xcc_id(); b.st = st;
    if (threadIdx.x == 0) (void)xb_add(&bar[XB_XCNT(b.x)], 1u);
    return b;
}
__device__ __forceinline__ void xcd_barrier_complete(unsigned* bar, unsigned x, unsigned& nloc, unsigned& nx) {
    const unsigned G = gridDim.x * gridDim.y * gridDim.z;
    unsigned sum, cnt, mine, sp = 0u;
    for (;;) {
        sum = 0u; cnt = 0u; mine = 0u;
#pragma unroll
        for (unsigned j = 0; j < 16; ++j) { const unsigned c = xb_ld(&bar[XB_XCNT(j)]); sum += c; cnt += (c > 0u) ? 1u : 0u; mine = (j == x) ? c : mine; }
        if (sum == G) break;
        __builtin_amdgcn_s_sleep(1);
        if ((++sp & 255u) == 0u) { if (xb_ld(&bar[XB_TMO])) break; if (sp > XB_SPIN_CAP) { atomicAdd(&bar[XB_TMO], 1u); break; } }
    }
    nloc = mine > 0u ? mine : 1u; nx = cnt > 0u ? cnt : 1u;
}

__device__ __forceinline__ void xcd_barrier(const XcdBarrier& b) {
    asm volatile("s_waitcnt vmcnt(0)" ::: "memory");
    __syncthreads();
    if (threadIdx.x == 0) {
        unsigned* bar = b.bar;
        __builtin_amdgcn_s_waitcnt(0);
        unsigned nloc = b.st[0], nx = b.st[1];
        if (nloc == 0u) { xcd_barrier_complete(bar, b.x, nloc, nx); b.st[0] = nloc; b.st[1] = nx; }
        const unsigned old = xb_add(&bar[XB_XSUB(b.x)], 1u);
        const unsigned gen = old / nloc;
        if (old + 1u == (gen + 1u) * nloc) {
            __builtin_amdgcn_fence(__ATOMIC_RELEASE, "agent");
            asm volatile("s_waitcnt vmcnt(0)" ::: "memory");
            const unsigned og = xb_add(&bar[XB_TOP], 1u);
            const unsigned tg = og / nx;
            if (og + 1u == (tg + 1u) * nx) xb_add(&bar[XB_TOPGEN], 1u);
            else XB_SPIN(xb_ld(&bar[XB_TOPGEN]) == tg, bar);
            __builtin_amdgcn_fence(__ATOMIC_ACQUIRE, "agent");
            xb_add(&bar[XB_XGEN(b.x)], 1u);
            asm volatile("s_waitcnt vmcnt(0)" ::: "memory");
        } else {
            XB_SPIN(xb_ld(&bar[XB_XGEN(b.x)]) == gen, bar);
            __builtin_amdgcn_fence(__ATOMIC_ACQUIRE, "agent");
            asm volatile("s_waitcnt vmcnt(0)" ::: "memory");
        }
    }
    __syncthreads();
}

namespace att {
constexpr int KPITCH = 144, BUF_BYTES = 2 * 64 * KPITCH, GK_OFF = 2 * BUF_BYTES, GQ_OFF = GK_OFF + 2 * 256, FLAG_OFF = GQ_OFF + 1024;
#define MFMA32(a, b, c) __builtin_amdgcn_mfma_f32_32x32x16_bf16((a), (b), (c), 0, 0, 0)
__device__ __forceinline__ void swap_halves(float v, float& lo, float& hi_) { auto rr = __builtin_amdgcn_permlane32_swap(__float_as_uint(v), __float_as_uint(v), false, false); lo = __uint_as_float(rr[0]); hi_ = __uint_as_float(rr[1]); }

struct Stage { v4u k, v; };
__device__ __forceinline__ void stage_load(Stage& s, const bf16* Kg, const bf16* Vg, int h, int j, int tid) {
    const int k_kv = tid >> 3, k_ch = tid & 7, v_kv = tid & 63, v_ch = tid >> 6;
    s.k = *(const v4u*)(Kg + (size_t)(64 * j + k_kv) * D + h * DH + k_ch * 8);
    s.v = *(const v4u*)(Vg + (size_t)(64 * j + v_kv) * D + h * DH + v_ch * 8);
}
__device__ __forceinline__ void stage_store(const Stage& s, LAS unsigned char* buf, int tid) {
    const int k_kv = tid >> 3, k_ch = tid & 7, v_kv = tid & 63, v_ch = tid >> 6;
    *(LAS v4u*)(buf + k_kv * KPITCH + k_ch * 16) = s.k;
    LAS unsigned short* vt = (LAS unsigned short*)(buf + 64 * KPITCH) + v_kv;
    const unsigned w[4] = {s.v.x, s.v.y, s.v.z, s.v.w};
#pragma unroll
    for (int i = 0; i < 4; ++i) { vt[(v_ch * 8 + 2 * i) * (KPITCH / 2)] = (unsigned short)(w[i] & 0xffffu); vt[(v_ch * 8 + 2 * i + 1) * (KPITCH / 2)] = (unsigned short)(w[i] >> 16); }
}
__device__ __forceinline__ void qk_tile(f32x16& S0, f32x16& S1, const LAS unsigned char* buf, const bf16x8 (&qf)[4], int r32, int hi) {
    const LAS unsigned char* kb = buf + r32 * KPITCH + hi * 16;
#pragma unroll
    for (int d0 = 0; d0 < 4; ++d0) { const bf16x8 a0 = *(const LAS bf16x8*)(kb + d0 * 32), a1 = *(const LAS bf16x8*)(kb + 32 * KPITCH + d0 * 32);
        S0 = MFMA32(a0, qf[d0], S0); S1 = MFMA32(a1, qf[d0], S1); }
}
__device__ __forceinline__ void pv_tile(f32x16& o0, f32x16& o1, const LAS unsigned char* buf, const float (&pw)[32], int r32, int hi) {
    const LAS unsigned char* vt = buf + 64 * KPITCH + r32 * KPITCH + hi * 8;
#pragma unroll
    for (int p = 0; p < 2; ++p)
#pragma unroll
        for (int s = 0; s < 2; ++s) { const int o = p * 16 + 8 * s;
            v4u pk; pk.x = cvtpk(pw[o], pw[o + 1]); pk.y = cvtpk(pw[o + 2], pw[o + 3]); pk.z = cvtpk(pw[o + 4], pw[o + 5]); pk.w = cvtpk(pw[o + 6], pw[o + 7]);
            const bf16x8 pb = __builtin_bit_cast(bf16x8, pk);
            const int kb = (32 * p + 16 * s) * 2;
            const s16x4 l0 = *(const LAS s16x4*)(vt + kb), h0 = *(const LAS s16x4*)(vt + kb + 16);
            const s16x4 l1 = *(const LAS s16x4*)(vt + 32 * KPITCH + kb), h1 = *(const LAS s16x4*)(vt + 32 * KPITCH + kb + 16);
            const bf16x8 a0 = __builtin_shufflevector(l0, h0, 0, 1, 2, 3, 4, 5, 6, 7), a1 = __builtin_shufflevector(l1, h1, 0, 1, 2, 3, 4, 5, 6, 7);
            o0 = MFMA32(a0, pb, o0); o1 = MFMA32(a1, pb, o1); }
}
__device__ __forceinline__ void store_o(bf16* Og, int tq, int h, const f32x16& o0, const f32x16& o1, float sc, int hi) {
    bf16* op = Og + (size_t)tq * D + h * DH + 4 * hi;
#pragma unroll
    for (int g = 0; g < 4; ++g) { v2u w0, w1; w0.x = cvtpk(o0[4 * g] * sc, o0[4 * g + 1] * sc); w0.y = cvtpk(o0[4 * g + 2] * sc, o0[4 * g + 3] * sc);
        w1.x = cvtpk(o1[4 * g] * sc, o1[4 * g + 1] * sc); w1.y = cvtpk(o1[4 * g + 2] * sc, o1[4 * g + 3] * sc);
        *(v2u*)(op + 8 * g) = w0; *(v2u*)(op + 32 + 8 * g) = w1; }
}

__device__ __forceinline__ void sb_unit(int h, int qb, const bf16* Qg, const bf16* Kg, const bf16* Vg, bf16* Og, LAS unsigned char* lds) {
    int tid_ = threadIdx.x; asm volatile("" : "+v"(tid_));
    const int tid = tid_, lane = tid & 63, r32 = lane & 31, hi = lane >> 5, wid = __builtin_amdgcn_readfirstlane(tid >> 6);
    const int q0 = qb * 256, t0w = q0 + wid * 32, tq = t0w + r32, jmax = 4 * qb + 3;
    volatile LAS int* flags = (volatile LAS int*)(lds + FLAG_OFF);
    __syncthreads();
    if (tid < 16) flags[tid] = 0;
    bf16x8 qf[4];
#pragma unroll
    for (int d0 = 0; d0 < 4; ++d0) qf[d0] = *(const bf16x8*)(Qg + (size_t)tq * D + h * DH + d0 * 16 + hi * 8);
    f32x16 o0 = {}, o1 = {}; float carry = 0.f; bool wdone = false;
    Stage st; stage_load(st, Kg, Vg, h, jmax, tid); stage_store(st, lds, tid);
    __syncthreads();
    for (int j = jmax, it = 0;; --j, ++it) {
        const int b = it & 1; LAS unsigned char* buf = lds + b * BUF_BYTES;
        if (it > 0) { int nd = 0;
#pragma unroll
            for (int w = 0; w < 8; ++w) nd += flags[((it - 1) & 1) * 8 + w];
            if (nd == 8) break; }
        const bool have_next = j > 0;
        if (have_next) stage_load(st, Kg, Vg, h, j - 1, tid);
        if (!wdone && 64 * j <= t0w) {
            f32x16 S0 = {}, S1 = {};
            qk_tile(S0, S1, buf, qf, r32, hi);
            const bool need_mask = 64 * j + 63 >= t0w;
            float ls[32], lgb[32];
#pragma unroll
            for (int p = 0; p < 2; ++p)
#pragma unroll
                for (int i = 0; i < 16; ++i) { const float z = p ? S1[i] : S0[i];
                    const float sp = fmaxf(z, 0.f) + lg2(1.f + ex2(-fabsf(z)));
                    const int kv = 64 * j + 32 * p + (i & 3) + 8 * (i >> 2) + 4 * hi;
                    const bool ok = !need_mask || (kv < tq);
                    ls[p * 16 + i] = ok ? -sp : 0.f; lgb[p * 16 + i] = ok ? (z - sp) : -INFINITY; }
            float base = carry;
#pragma unroll
            for (int p = 1; p >= 0; --p)
#pragma unroll
                for (int g = 3; g >= 0; --g) { const int o = p * 16 + 4 * g;
                    const float s3 = ls[o + 3], s2 = s3 + ls[o + 2], s1 = s2 + ls[o + 1], G = s1 + ls[o];
                    float Glo, Ghi; swap_halves(G, Glo, Ghi);
                    const float bl = base + (hi ? 0.f : Ghi);
                    lgb[o + 3] = ex2(lgb[o + 3] + bl); lgb[o + 2] = ex2(lgb[o + 2] + (bl + s3)); lgb[o + 1] = ex2(lgb[o + 1] + (bl + s2)); lgb[o] = ex2(lgb[o] + (bl + s1));
                    base += Glo + Ghi; }
            carry = base;
            pv_tile(o0, o1, buf, lgb, r32, hi);
            wdone = __all(carry < -THR2);
        }
        if (lane == 0) flags[b * 8 + wid] = wdone ? 1 : 0;
        if (have_next) stage_store(st, lds + (b ^ 1) * BUF_BYTES, tid);
        __syncthreads();
        if (!have_next) break;
    }
    store_o(Og, tq, h, o0, o1, 1.f, hi);
}

__device__ __forceinline__ float suffix_scan_excl(float v, int lane, float& total) {
    float inc = v;
#pragma unroll
    for (int off = 1; off < 64; off <<= 1) { const float t = __shfl_down(inc, off); if (lane + off < 64) inc += t; }
    total = __shfl(inc, 0); return inc - v;
}
__device__ __forceinline__ void fox_unit(int h, int qb, const bf16* Qg, const bf16* Kg, const bf16* Vg, bf16* Og, const float* LS2, float bound2, LAS unsigned char* lds) {
    int tid_ = threadIdx.x; asm volatile("" : "+v"(tid_));
    const int tid = tid_, lane = tid & 63, r32 = lane & 31, hi = lane >> 5, wid = __builtin_amdgcn_readfirstlane(tid >> 6);
    const int q0 = qb * 256, t0w = q0 + wid * 32, tq = t0w + r32, jmax = 4 * qb + 3;
    volatile LAS int* flags = (volatile LAS int*)(lds + FLAG_OFF);
    LAS float* GK = (LAS float*)(lds + GK_OFF); LAS float* GQ = (LAS float*)(lds + GQ_OFF);
    const float* lsh = LS2 + (size_t)h * M;
    __syncthreads();
    if (tid < 16) flags[tid] = 0;
    float cgk = 0.f;
    if (wid == 0) { float c = 0.f;
        for (int jj = jmax; jj > jmax - 4; --jj) { float tot; const float ex = suffix_scan_excl(lsh[64 * jj + lane], lane, tot); GQ[(jj - 4 * qb) * 64 + lane] = c + ex; c += tot; }
        float tot; const float ex = suffix_scan_excl(lsh[64 * jmax + lane], lane, tot); GK[lane] = ex; cgk = tot; }
    bf16x8 qf[4];
#pragma unroll
    for (int d0 = 0; d0 < 4; ++d0) qf[d0] = *(const bf16x8*)(Qg + (size_t)tq * D + h * DH + d0 * 16 + hi * 8);
    f32x16 o0 = {}, o1 = {}; float mrun = -INFINITY, lsum = 0.f; bool wdone = false;
    Stage st; stage_load(st, Kg, Vg, h, jmax, tid); stage_store(st, lds, tid);
    __syncthreads();
    const float gq = GQ[wid * 32 + r32], gq0 = GQ[wid * 32];
    for (int j = jmax, it = 0;; --j, ++it) {
        const int b = it & 1; LAS unsigned char* buf = lds + b * BUF_BYTES; const LAS float* gkb = GK + b * 64;
        if (it > 0) { int nd = 0;
#pragma unroll
            for (int w = 0; w < 8; ++w) nd += flags[((it - 1) & 1) * 8 + w];
            if (nd == 8) break; }
        const bool have_next = j > 0;
        float gnext = 0.f;
        if (have_next) { stage_load(st, Kg, Vg, h, j - 1, tid); if (wid == 0) gnext = lsh[64 * (j - 1) + lane]; }
        if (!wdone && 64 * j <= t0w) {
            if (gkb[63] - gq0 + bound2 < -THR2) wdone = true;
            else {
                f32x16 S0 = {}, S1 = {};
                qk_tile(S0, S1, buf, qf, r32, hi);
                const bool need_mask = 64 * j + 63 > t0w;
                float x[32]; float tmax = -INFINITY;
#pragma unroll
                for (int p = 0; p < 2; ++p)
#pragma unroll
                    for (int g = 0; g < 4; ++g) { const f32x4 gk4 = *(const LAS f32x4*)(gkb + 32 * p + 8 * g + 4 * hi);
#pragma unroll
                        for (int e = 0; e < 4; ++e) { const int i = 4 * g + e; const float z = p ? S1[i] : S0[i];
                            const int kv = 64 * j + 32 * p + 8 * g + 4 * hi + e;
                            float v = z + (gk4[e] - gq);
                            if (need_mask && kv > tq) v = -INFINITY;
                            x[p * 16 + i] = v; tmax = fmaxf(tmax, v); } }
                float tl, th; swap_halves(tmax, tl, th); tmax = fmaxf(tl, th);
                const float mnew = fmaxf(mrun, tmax), alpha = ex2(mrun - mnew); mrun = mnew;
                float ps = 0.f;
#pragma unroll
                for (int i = 0; i < 32; ++i) { x[i] = ex2(x[i] - mnew); ps += x[i]; }
                lsum = lsum * alpha + ps;
#pragma unroll
                for (int i = 0; i < 16; ++i) { o0[i] *= alpha; o1[i] *= alpha; }
                pv_tile(o0, o1, buf, x, r32, hi);
            }
        }
        if (lane == 0) flags[b * 8 + wid] = wdone ? 1 : 0;
        if (have_next) { stage_store(st, lds + (b ^ 1) * BUF_BYTES, tid);
            if (wid == 0) { float tot; const float ex = suffix_scan_excl(gnext, lane, tot); GK[(b ^ 1) * 64 + lane] = cgk + ex; cgk += tot; } }
        __syncthreads();
        if (!have_next) break;
    }
    float ll, lh; swap_halves(lsum, ll, lh);
    store_o(Og, tq, h, o0, o1, __builtin_amdgcn_rcpf(ll + lh), hi);
}
#undef MFMA32
}

struct Frame { LAS unsigned char* lds; int tid, lane, wave, vcu, G; };
__device__ __forceinline__ float wave_sum(float v) {
#pragma unroll
    for (int o = 1; o < 64; o <<= 1) v += __shfl_xor(v, o);
    return v;
}
__device__ __forceinline__ float wave_max(float v) {
#pragma unroll
    for (int o = 1; o < 64; o <<= 1) v = fmaxf(v, __shfl_xor(v, o));
    return v;
}
template <int MAP> __device__ __forceinline__ void tr_item(const float* W, int K, int ldw, int csrc0, int nblk, const float* gain, bf16* WT, LAS float* scr, int item, int lane) {
    const int kb = item / nblk, nb = item % nblk, k0 = 64 * kb, n0 = 32 * nb;
    int v0;
    if (MAP == 0) v0 = n0;
    else if (MAP == 1) { const int head = n0 >> 6, bj = (n0 >> 5) & 1; v0 = 256 * (head >> 2) + 128 * bj + 32 * (head & 3); }
    else { const int isu = n0 >= FF, c = isu ? n0 - FF : n0; v0 = 256 * (c >> 7) + 128 * isu + (c & 127); }
#pragma unroll 8
    for (int i = 0; i < 32; ++i) { const int kk = 2 * i + (lane >> 5); float w = W[(size_t)(k0 + kk) * ldw + csrc0 + n0 + (lane & 31)]; if (gain) w *= gain[k0 + kk]; scr[kk * 33 + (lane & 31)] = w; }
    LDS_WAIT(); asm volatile("" ::: "memory");
    const int c = lane & 7;
#pragma unroll
    for (int j = 0; j < 4; ++j) { const int n = (lane >> 3) + 8 * j; const LAS float* s = scr + (8 * c) * 33 + n;
        v4u o; o.x = pk2(s[0 * 33], s[1 * 33]); o.y = pk2(s[2 * 33], s[3 * 33]); o.z = pk2(s[4 * 33], s[5 * 33]); o.w = pk2(s[6 * 33], s[7 * 33]);
        *(v4u*)(WT + (size_t)(v0 + n) * K + k0 + 8 * c) = o; }
    LDS_WAIT(); asm volatile("" ::: "memory");
}


struct Args { const float* in[18]; float* out; unsigned char* ws; };
typedef const __attribute__((address_space(4))) Args* ArgsP;
__device__ __forceinline__ ArgsP argp() { ArgsP p = (ArgsP)__builtin_amdgcn_kernarg_segment_ptr(); asm volatile("" : "+s"(p)); return p; }
#define WSP(T, off) ((T*)(A->ws + (off)))
enum { IN_X = 0, IN_P, IN_ATTN_G, IN_SB_WQKV, IN_SB_WO, IN_SHARED_G, IN_WKVF, IN_BF, IN_KNORM_G, IN_FOX_WQ, IN_QNORM_G, IN_FOX_WO, IN_FFN_G, IN_WGU, IN_WD, IN_PLE_G, IN_WGATE, IN_WPROJ };

__device__ __forceinline__ void convert_p(const Frame& F, const float* psrc, bf16* pdst) {
    const int gw = F.vcu * NWAVES + F.wave, NGW = F.G * NWAVES; const f32x4* ps = (const f32x4*)psrc; v2u* pd = (v2u*)pdst;
    for (int i = gw * 64 + F.lane; i < M * PLE / 4; i += NGW * 64) { const f32x4 v = ps[i]; v2u w; w.x = pk2(v.x, v.y); w.y = pk2(v.z, v.w); pd[i] = w; }
}

__device__ __forceinline__ void prologue(const Frame& F) {
    ArgsP A = argp();
    LAS float* scr = (LAS float*)(F.lds + F.wave * 16384);
    const int gw = F.vcu * NWAVES + F.wave, NGW = F.G * NWAVES;
    constexpr int I0 = 16 * 96, I1 = 512, I2 = 512, I3 = 512, I4 = 512, I5 = 512, I6 = 16 * 176, I7 = 44 * 32, I8 = 512, I9 = 4 * 32;
    constexpr int NITEMS = I0 + I1 + I2 + I3 + I4 + I5 + 2 * I6 + 2 * I7 + 2 * I8 + 2 * I9;
    for (int it = gw; it < NITEMS; it += NGW) {
        int r = it;
        if (r < I0) { tr_item<0>(A->in[IN_SB_WQKV], D, 3 * D, 0, 96, A->in[IN_ATTN_G], WSP(bf16, WS_WQKV0), scr, r, F.lane); continue; } r -= I0;
        if (r < I1) { tr_item<0>(A->in[IN_SB_WO], D, D, 0, 32, nullptr, WSP(bf16, WS_WO0), scr, r, F.lane); continue; } r -= I1;
        if (r < I2) { tr_item<1>(A->in[IN_WKVF], D, 2 * D + NH, 0, 32, A->in[IN_SHARED_G], WSP(bf16, WS_WKVQ1), scr, r, F.lane); continue; } r -= I2;
        if (r < I3) { tr_item<1>(A->in[IN_WKVF], D, 2 * D + NH, D, 32, A->in[IN_SHARED_G], WSP(bf16, WS_WKVQ1) + (size_t)D * D, scr, r, F.lane); continue; } r -= I3;
        if (r < I4) { tr_item<1>(A->in[IN_FOX_WQ], D, D, 0, 32, A->in[IN_ATTN_G] + D, WSP(bf16, WS_WKVQ1) + (size_t)2 * D * D, scr, r, F.lane); continue; } r -= I4;
        if (r < I5) { tr_item<0>(A->in[IN_FOX_WO], D, D, 0, 32, nullptr, WSP(bf16, WS_WO1), scr, r, F.lane); continue; } r -= I5;
        if (r < 2 * I6) { const int l = r / I6; tr_item<2>(A->in[IN_WGU] + (size_t)l * D * 2 * FF, D, 2 * FF, 0, 176, A->in[IN_FFN_G] + l * D, WSP(bf16, WS_WGU) + (size_t)l * 2 * FF * D, scr, r % I6, F.lane); continue; } r -= 2 * I6;
        if (r < 2 * I7) { const int l = r / I7; tr_item<0>(A->in[IN_WD] + (size_t)l * FF * D, FF, D, 0, 32, nullptr, WSP(bf16, WS_WD) + (size_t)l * D * FF, scr, r % I7, F.lane); continue; } r -= 2 * I7;
        if (r < 2 * I8) { const int l = r / I8; tr_item<0>(A->in[IN_WGATE] + (size_t)l * D * D, D, D, 0, 32, A->in[IN_PLE_G] + l * D, WSP(bf16, WS_WG) + (size_t)l * D * D, scr, r % I8, F.lane); continue; } r -= 2 * I8;
        { const int l = r / I9; tr_item<0>(A->in[IN_WPROJ] + (size_t)l * PLE * D, PLE, D, 0, 32, nullptr, WSP(bf16, WS_WP) + (size_t)l * D * PLE, scr, r % I9, F.lane); }
    }
    { const float* wk = A->in[IN_WKVF]; const float* sg = A->in[IN_SHARED_G]; bf16* WF = WSP(bf16, WS_WF);
      for (int i = gw * 64 + F.lane; i < NH * D; i += NGW * 64) { const int n = i >> 10, k = i & 1023; WF[i] = (bf16)f2bf(wk[(size_t)k * (2 * D + NH) + 2 * D + n] * sg[k]); } }
    { const float* x = A->in[IN_X]; bf16* HBA = WSP(bf16, WS_HBA); float* SSQ = WSP(float, WS_SSQ);
      for (int m = gw; m < M; m += NGW) {
        const f32x4* xr = (const f32x4*)(x + (size_t)m * D) + F.lane; f32x4 v[4]; float s = 0.f;
#pragma unroll
        for (int j = 0; j < 4; ++j) { v[j] = xr[64 * j]; s += (v[j].x * v[j].x + v[j].y * v[j].y) + (v[j].z * v[j].z + v[j].w * v[j].w); }
        s = wave_sum(s);
        v2u* o8 = (v2u*)(HBA + (size_t)m * D) + F.lane;
#pragma unroll
        for (int j = 0; j < 4; ++j) { v2u w; w.x = pk2(v[j].x, v[j].y); w.y = pk2(v[j].z, v[j].w); o8[64 * j] = w; }
        if (F.lane == 0) *(f32x4*)(SSQ + (size_t)m * 4) = (f32x4){s, 0.f, 0.f, 0.f};
      } }
}


#ifdef DBG
__device__ __forceinline__ float bf2f(bf16 v) { return __uint_as_float((unsigned)v << 16); }
__device__ __forceinline__ float sp2(float z) { return fmaxf(z, 0.f) + lg2(1.f + ex2(-fabsf(z))); }
__device__ __forceinline__ float row_rinv_direct(const float* row, int lane) { float s = 0.f; for (int k = lane; k < D; k += 64) s += row[k] * row[k]; s = wave_sum(s); return rsqrtf(s * (1.f / D) + 1e-6f); }
__device__ __forceinline__ float dotcol(const float* row, const float* g, const float* W, int K, int ldw, int c, int lane) { float s = 0.f; for (int k = lane; k < K; k += 64) s += row[k] * (g ? g[k] : 1.f) * W[(size_t)k * ldw + c]; return wave_sum(s); }
__device__ __forceinline__ float dotcol_bf(const bf16* row, const float* W, int K, int ldw, int c, int lane) { float s = 0.f; for (int k = lane; k < K; k += 64) s += bf2f(row[k]) * W[(size_t)k * ldw + c]; return wave_sum(s); }
__device__ __forceinline__ void dbg_rec(float* dbg, int slot, float err) { if (err > dbg[slot] || !(err == err)) dbg[slot] = (err == err) ? err : 1e9f; }
#define TS(s) ((s) == 0 ? 5 : (s) == 1 ? 300 : (s) == 2 ? 4097 : 16383)
#define CS4(s) ((s) == 0 ? 3 : (s) == 1 ? 300 : (s) == 2 ? 777 : 1023)
__device__ __forceinline__ void dbg_check(int stage, const Frame& F) {
    if (blockIdx.x != 0 || F.wave != 0) return;
    ArgsP A = argp(); const int lane = F.lane;
    float* dbg = WSP(float, 32768);
    const float* x = A->in[IN_X]; float* out = A->out;
    const bf16* QB = WSP(bf16, WS_Q); const bf16* KB = WSP(bf16, WS_K); const bf16* VB = WSP(bf16, WS_V); const bf16* ACT = WSP(bf16, WS_ACT);
    if (stage == 1) {
        for (int s = 0; s < 6; ++s) { const int t = TS(s & 3), c = (s == 0 ? 5 : s == 1 ? 700 : s == 2 ? 1029 : s == 3 ? 2000 : s == 4 ? 2100 : 3000); const float* row = x + (size_t)t * D;
            const float ri = row_rinv_direct(row, lane); float ref = dotcol(row, A->in[IN_ATTN_G], A->in[IN_SB_WQKV], D, 3 * D, c, lane) * ri; if (c < 1024) ref *= QSCALE;
            const float got = bf2f(QB[(size_t)(c >> 10) * M * D + (size_t)t * D + (c & 1023)]);
            if (lane == 0) dbg_rec(dbg, 1, fabsf(ref - got) / (fabsf(ref) + 0.3f)); }
    } else if (stage == 2) {
        for (int s = 0; s < 4; ++s) { const int t = TS(s), h = (s == 0 ? 0 : s == 1 ? 3 : s == 2 ? 7 : 15); const float* row = x + (size_t)t * D; const float ri = row_rinv_direct(row, lane);
            float q = 0.f; for (int k = 0; k < D; ++k) q += row[k] * A->in[IN_ATTN_G][k] * A->in[IN_SB_WQKV][(size_t)k * 3 * D + h * 64 + lane]; q *= ri * QSCALE;
            float later = 0.f, o = 0.f;
            for (int kk = t - 1; kk >= 0 && kk >= t - 600; --kk) { const float z = wave_sum(q * bf2f(KB[(size_t)kk * D + h * 64 + lane])); const float sp = sp2(z);
                const float w = ex2(z - sp + later); later -= sp; o += w * bf2f(VB[(size_t)kk * D + h * 64 + lane]); }
            const float got = bf2f(QB[(size_t)t * D + h * 64 + lane]); const float e = wave_max(fabsf(o - got));
            if (lane == 0) dbg_rec(dbg, 2, e); }
    } else if (stage == 3) {
        for (int s = 0; s < 4; ++s) { const int t = TS(s), c = CS4(s);
            const float ref = x[(size_t)t * D + c] + dotcol_bf(QB + (size_t)t * D, A->in[IN_SB_WO], D, D, c, lane); const float got = out[(size_t)t * D + c];
            if (lane == 0) { dbg_rec(dbg, 3, fabsf(ref - got) / (fabsf(ref) + 0.3f)); dbg[64 + s] = got; }
            float ss = 0.f; for (int k = lane; k < D; k += 64) ss += out[(size_t)t * D + k] * out[(size_t)t * D + k]; ss = wave_sum(ss);
            const float* sq = WSP(float, WS_SSQ + (size_t)1 * M * 16) + (size_t)t * 4; const float got2 = sq[0] + sq[1] + sq[2] + sq[3];
            if (lane == 0) dbg_rec(dbg, 4, fabsf(ss - got2) / (ss + 1.f)); }
    } else if (stage == 4) {
        for (int s = 0; s < 4; ++s) { const int t = TS(s), j = (s == 0 ? 1 : s == 1 ? 130 : s == 2 ? 1500 : 2815); const float* row = out + (size_t)t * D; const float ri = row_rinv_direct(row, lane);
            const float g = dotcol(row, A->in[IN_FFN_G], A->in[IN_WGU], D, 2 * FF, j, lane) * ri, u = dotcol(row, A->in[IN_FFN_G], A->in[IN_WGU], D, 2 * FF, FF + j, lane) * ri;
            const float ref = g / (1.f + expf(-g)) * u, got = bf2f(ACT[(size_t)t * FF + j]);
            if (lane == 0) dbg_rec(dbg, 5, fabsf(ref - got) / (fabsf(ref) + 0.3f)); }
    } else if (stage == 5) {
        for (int s = 0; s < 4; ++s) { const int t = TS(s), c = CS4(s);
            const float ref = dbg[64 + s] + dotcol_bf(ACT + (size_t)t * FF, A->in[IN_WD], FF, D, c, lane), got = out[(size_t)t * D + c];
            if (lane == 0) dbg_rec(dbg, 6, fabsf(ref - got) / (fabsf(ref) + 0.3f)); }
        for (int s = 0; s < 4; ++s) for (int k = lane; k < D; k += 64) dbg[128 + s * D + k] = out[(size_t)TS(s) * D + k];
    } else if (stage == 6) {
        for (int s = 0; s < 4; ++s) { const int t = TS(s), c = CS4(s); const float* row = dbg + 128 + s * D; const float ri = row_rinv_direct(row, lane);
            const float a = dotcol(row, A->in[IN_PLE_G], A->in[IN_WGATE], D, D, c, lane) * ri; const float pr = dotcol(A->in[IN_P] + (size_t)t * PLE, nullptr, A->in[IN_WPROJ], PLE, D, c, lane);
            const float ref = row[c] + pr / (1.f + expf(-a)), got = out[(size_t)t * D + c];
            if (lane == 0) { dbg_rec(dbg, 7, fabsf(ref - got) / (fabsf(ref) + 0.3f)); const float pb = bf2f(WSP(bf16, WS_PROJ)[(size_t)t * D + c]); dbg_rec(dbg, 5, fabsf(pr - pb) / (fabsf(pr) + 0.3f)); } }
    }
    __builtin_amdgcn_s_waitcnt(0);
}
__device__ __forceinline__ void dbg_finish(const Frame& F) {
    if (blockIdx.x != 0 || F.tid != 0) return;
    ArgsP A = argp(); const float* dbg = WSP(float, 32768);
    int code = 0; for (int s = 7; s >= 1; --s) if (dbg[s] > 0.06f) code = s;
    A->out[0] = 10000.f * (float)code + 1000.f * fminf(dbg[code ? code : 1] * 10.f, 9.f) + 100.f;
}
#define DBG_CHECK(s) do { dbg_check((s), F); xcd_barrier(bar); } while (0)
#else
#define DBG_CHECK(s) do {} while (0)
#endif
template <int L> __device__ __forceinline__ void layer(const Frame& F, const XcdBarrier& bar) {
    constexpr size_t SSQ_A = WS_SSQ + (size_t)(3 * L) * M * 16, SSQ_B = WS_SSQ + (size_t)(3 * L + 1) * M * 16, SSQ_C = WS_SSQ + (size_t)(3 * L + 2) * M * 16, SSQ_D = WS_SSQ + (size_t)(3 * L + 3) * M * 16;
    if (L == 0) {
        ArgsP A = argp();
        pg8::Gemm g{WSP(bf16, WS_HBA), WSP(bf16, WS_WQKV0), M, 3 * D, D}; pg8::StaticOrder S; S.init(M, 3 * D, F.G, (int)blockIdx.x);
        pg8::EpiQKV0 E{WSP(bf16, WS_Q), (size_t)M * D, WSP(float, SSQ_A), QSCALE};
        pg8::gemm_phase<pg8::EpiQKV0, pg8::StaticOrder, true, true>(F.lds, g, S, E);
    } else {
        { ArgsP A = argp(); const bf16* HBB = WSP(bf16, WS_HBB); const bf16* WF = WSP(bf16, WS_WF); float* LS2 = WSP(float, WS_LS2); const float* ssq = WSP(float, SSQ_A); const float* b_f = A->in[IN_BF];
          for (int rb = blockIdx.x; rb < M / 64; rb += F.G) {
            if (F.wave < 4) { const int fr = F.lane & 15, fq = F.lane >> 4, row0 = rb * 64 + F.wave * 16;
                const bf16* ap = HBB + (size_t)(row0 + fr) * D + 8 * fq; const bf16* bp = WF + (size_t)fr * D + 8 * fq;
                f32x4 acc = {0.f, 0.f, 0.f, 0.f};
#pragma unroll 8
                for (int kk = 0; kk < 32; ++kk) { const bf16x8 a = *(const bf16x8*)(ap + kk * 32), b = *(const bf16x8*)(bp + kk * 32); acc = __builtin_amdgcn_mfma_f32_16x16x32_bf16(a, b, acc, 0, 0, 0); }
                const float bias = b_f[fr]; f32x4 o;
#pragma unroll
                for (int i = 0; i < 4; ++i) { const float f2 = (acc[i] * pg8::row_rinv(ssq, row0 + 4 * fq + i) + bias) * LOG2E_F;
                    o[i] = -(fmaxf(-f2, 0.f) + lg2(1.f + ex2(-fabsf(f2)))); }
                *(f32x4*)(LS2 + (size_t)fr * M + row0 + 4 * fq) = o; }
          } }
        ArgsP A = argp();
        pg8::Gemm g{WSP(bf16, WS_HBB), WSP(bf16, WS_WKVQ1), M, 3 * D, D}; pg8::StaticOrder S; S.init(M, 3 * D, F.G, (int)blockIdx.x);
        pg8::EpiKVQ1 E{WSP(bf16, WS_Q), (size_t)M * D, WSP(float, SSQ_A), A->in[IN_KNORM_G], A->in[IN_QNORM_G], QSCALE};
        pg8::gemm_phase<pg8::EpiKVQ1, pg8::StaticOrder, true, true>(F.lds, g, S, E);
    }
    xcd_barrier(bar);
    if (L == 0) DBG_CHECK(1);
    {
        ArgsP A = argp();
        float bound2 = 0.f;
        if (L == 1) { const float mq = wave_max(fabsf(A->in[IN_QNORM_G][F.lane])), mk = wave_max(fabsf(A->in[IN_KNORM_G][F.lane])); bound2 = 2.0f * 1.02f * 8.0f * LOG2E_F * mq * mk; }
        bf16* QB = WSP(bf16, WS_Q); const bf16* KB = WSP(bf16, WS_K); const bf16* VB = WSP(bf16, WS_V); const float* LS2 = WSP(float, WS_LS2);
        for (int un = F.vcu; un < NH * (M / 256); un += F.G) { const int h = un >> 6, qb = un & 63;
            if (L == 0) att::sb_unit(h, qb, QB, KB, VB, QB, F.lds);
            else att::fox_unit(h, qb, QB, KB, VB, QB, LS2, bound2, F.lds); }
        __syncthreads();
    }
    xcd_barrier(bar);
    if (L == 0) DBG_CHECK(2);
    { ArgsP A = argp(); convert_p(F, A->in[IN_P] + (size_t)L * M * PLE, WSP(bf16, WS_PBUF)); }
    for (int idx = blockIdx.x; idx < 256; idx += F.G) {
        ArgsP A = argp();
        pg8::StaticOrder S0; S0.init(M, D, 256, idx); pg8::OneUnit S; S0.next(0, S.u);
        pg8::Gemm g{WSP(bf16, WS_Q), WSP(bf16, L == 0 ? WS_WO0 : WS_WO1), M, D, D};
        pg8::EpiRes E{L == 0 ? A->in[IN_X] : (const float*)A->out, A->out, WSP(bf16, WS_HBA), WSP(float, SSQ_B)};
        pg8::gemm_phase<pg8::EpiRes, pg8::OneUnit, false, true>(F.lds, g, S, E);
    }
    xcd_barrier(bar);
    if (L == 0) DBG_CHECK(3);
    {
        ArgsP A = argp();
        pg8::Gemm g{WSP(bf16, WS_HBA), WSP(bf16, WS_WGU) + (size_t)L * 2 * FF * D, M, 2 * FF, D}; pg8::StaticOrder S; S.init(M, 2 * FF, F.G, (int)blockIdx.x);
        pg8::EpiGU E{WSP(bf16, WS_ACT), WSP(float, SSQ_B)};
        pg8::gemm_phase<pg8::EpiGU, pg8::StaticOrder, true, true>(F.lds, g, S, E);
    }
    xcd_barrier(bar);
    if (L == 0) DBG_CHECK(4);
    for (int idx = blockIdx.x; idx < 256; idx += F.G) {
        ArgsP A = argp();
        pg8::StaticOrder S0; S0.init(M, D, 256, idx); pg8::OneUnit S; S0.next(0, S.u);
        pg8::Gemm g{WSP(bf16, WS_ACT), WSP(bf16, WS_WD) + (size_t)L * D * FF, M, D, FF};
        pg8::EpiRes E{A->out, A->out, WSP(bf16, WS_HBA), WSP(float, SSQ_C)};
        pg8::gemm_phase<pg8::EpiRes, pg8::OneUnit, false, true>(F.lds, g, S, E);
    }
    xcd_barrier(bar);
    if (L == 0) DBG_CHECK(5);
    for (int idx = blockIdx.x; idx < 256; idx += F.G) {
        pg8::StaticOrder S0; S0.init(M, D, 256, idx); pg8::OneUnit S; S0.next(0, S.u);
        { ArgsP A = argp(); pg8::Gemm g{WSP(bf16, WS_PBUF), WSP(bf16, WS_WP) + (size_t)L * D * PLE, M, D, PLE}; pg8::EpiProj E{WSP(bf16, WS_PROJ)};
          pg8::gemm_phase<pg8::EpiProj, pg8::OneUnit, false, true>(F.lds, g, S, E); }
        asm volatile("s_waitcnt vmcnt(0)" ::: "memory"); __syncthreads();
        { ArgsP A = argp(); pg8::Gemm g{WSP(bf16, WS_HBA), WSP(bf16, WS_WG) + (size_t)L * D * D, M, D, D};
          pg8::EpiPle E{WSP(float, SSQ_C), WSP(bf16, WS_PROJ), A->out, L == 0 ? WSP(bf16, WS_HBB) : (bf16*)nullptr, L == 0 ? WSP(float, SSQ_D) : (float*)nullptr};
          pg8::gemm_phase<pg8::EpiPle, pg8::OneUnit, false, true>(F.lds, g, S, E); }
    }
    if (L == 0) { xcd_barrier(bar); DBG_CHECK(6); }
#ifdef DBG
    if (L == 1) { xcd_barrier(bar); dbg_finish(F); }
#endif
}

__global__ void __launch_bounds__(NWAVES * 64, 2) mega_fwd(Args args) {
    extern __shared__ __attribute__((aligned(16))) unsigned char lds_raw[];
    Frame F;
    F.lds = (LAS unsigned char*)lds_raw;
    F.tid = threadIdx.x; F.lane = F.tid & 63; F.wave = __builtin_amdgcn_readfirstlane(F.tid >> 6);
    F.G = gridDim.x; { const int bx = blockIdx.x; F.vcu = (F.G % 8 == 0) ? (bx % 8) * (F.G / 8) + bx / 8 : bx; }
    volatile LAS unsigned* MISC = (volatile LAS unsigned*)(F.lds + MISC_OFF);
    for (int u = F.tid; u < (LDS_BYTES - RING_BYTES) / 4; u += NWAVES * 64) ((LAS unsigned*)(F.lds + RING_BYTES))[u] = 0u;
    __syncthreads();
    XcdBarrier bar;
    { ArgsP A = argp(); bar = xcd_barrier_post(WSP(unsigned, WS_CTL) + CW_BAR, MISC + 8); }
    prologue(F);
    cg::this_grid().sync();
    layer<0>(F, bar);
    layer<1>(F, bar);
    (void)args;
}

extern "C" void kernel_launch(void* const* d_in, const int* in_sizes, int n_in, void* d_out, int out_size, void* d_ws, size_t ws_size, hipStream_t stream) {
    static int grid = 0;
    if (grid == 0) {
        if (n_in != 18 || in_sizes[0] != M * D || out_size != M * D || ws_size < WS_END) { fprintf(stderr, "kernel_launch: unexpected shapes (n_in %d, in0 %d, out %d, ws %zu); nothing launched\n", n_in, n_in > 0 ? in_sizes[0] : -1, out_size, ws_size); grid = -1; return; }
        int dev = 0, cus = 0, per_cu = 0;
        if (hipGetDevice(&dev) != hipSuccess || hipDeviceGetAttribute(&cus, hipDeviceAttributeMultiprocessorCount, dev) != hipSuccess) { fprintf(stderr, "kernel_launch: device query failed\n"); grid = -1; return; }
        if (hipFuncSetAttribute((const void*)mega_fwd, hipFuncAttributeMaxDynamicSharedMemorySize, LDS_BYTES) != hipSuccess) { fprintf(stderr, "kernel_launch: hipFuncSetAttribute failed\n"); grid = -1; return; }
        if (hipOccupancyMaxActiveBlocksPerMultiprocessor(&per_cu, (const void*)mega_fwd, NWAVES * 64, LDS_BYTES) != hipSuccess || per_cu < 1) { fprintf(stderr, "kernel_launch: occupancy query says %d\n", per_cu); per_cu = 1; }
        (void)hipGetLastError();
        grid = cus * per_cu;
    }
    if (grid < 0) return;
    if (hipMemsetAsync((char*)d_ws + WS_CTL, 0, CTL_ZERO_BYTES, stream) != hipSuccess) { fprintf(stderr, "kernel_launch: memset failed\n"); return; }
    Args a{};
    for (int i = 0; i < 18; ++i) a.in[i] = (const float*)d_in[i];
    a.out = (float*)d_out; a.ws = (unsigned char*)d_ws;
    void* kargs[] = {&a};
    const hipError_t e = hipLaunchCooperativeKernel((const void*)mega_fwd, dim3(grid), dim3(NWAVES * 64), kargs, LDS_BYTES, stream);
    if (e != hipSuccess) fprintf(stderr, "kernel_launch: cooperative launch failed: %s (grid %d)\n", hipGetErrorString(e), grid);
}
```

```cpp
#include <hip/hip_runtime.h>
#include <hip/hip_cooperative_groups.h>
#include <cstdio>
#include <cstdint>
namespace cg = cooperative_groups;
namespace pg8 {
#define PG8_LAS __attribute__((address_space(3)))
typedef unsigned short bf16_t;
typedef short bf16x8 __attribute__((ext_vector_type(8)));
typedef float f32x4 __attribute__((ext_vector_type(4)));
typedef unsigned u32x4 __attribute__((ext_vector_type(4)));
constexpr int BM = 256, BK = 64, HALF = 128, HTB = HALF * BK * 2  , STAGE_BYTES = 8 * HTB, NXCD = 8, WGM = 8;

__host__ __device__ __forceinline__ int lds_byte(int r, int c) { const int st = (r >> 4) * 2 + (c >> 5), rr = r & 15, cc = c & 31, ob = rr * 64 + cc * 2; return st * 1024 + (ob ^ (((ob >> 9) & 1) << 5)); }
__host__ __device__ __forceinline__ void stage_rc(int b, int& R, int& C) { const int st = b / 1024, sb = b % 1024, swz = sb ^ (((sb >> 9) & 1) << 5); R = (st >> 1) * 16 + swz / 64; C = (st & 1) * 32 + (swz % 64) / 2; }
__host__ __device__ __forceinline__ int perm32(int rho) { const int n = rho >> 4, i = rho & 15; return 8 * (i >> 2) + 4 * n + (i & 3); }

struct Unit { int pm, pn; };
struct Gemm { const bf16_t* A; const bf16_t* Bt; int M, N, K; };

struct StaticOrder {
    int nM, nN, nwg, G, c;
    __host__ __device__ void init(int M, int N, int G_, int c_) { nM = M / BM; nN = N / BM; nwg = nM * nN; G = G_; c = c_; }
    __host__ __device__ bool next(int i, Unit& u) const {
        const long L = (long)i * G + c; if (L >= nwg) return false;
        int wgid = (int)L; { const int q = nwg / NXCD, r = nwg % NXCD, xcd = wgid % NXCD, off = wgid / NXCD; wgid = (xcd < r ? xcd * (q + 1) : r * (q + 1) + (xcd - r) * q) + off; }
        const int nig = WGM * nN, gid = wgid / nig, fm = gid * WGM, gsz = (nM - fm) < WGM ? (nM - fm) : WGM;
        u.pm = fm + ((wgid % nig) % gsz); u.pn = (wgid % nig) / gsz; return true;
    }
    __device__ __forceinline__ void a_ready(const Unit&) const {}
    __device__ __forceinline__ void done(const Unit&) const {}
};


typedef unsigned u32x2 __attribute__((ext_vector_type(2)));
__device__ __forceinline__ unsigned cvt_pk_bf16(float lo, float hi) { unsigned r; asm volatile("v_cvt_pk_bf16_f32 %0, %1, %2" : "=v"(r) : "v"(lo), "v"(hi)); return r; }
constexpr float RMS_EPS = 1e-6f, LOG2E = 1.4426950408889634f;
__device__ __forceinline__ float row_rinv(const float* ssq, int row) { const f32x4 s = *(const f32x4*)(ssq + (size_t)row * 4); return rsqrtf(((s[0] + s[1]) + (s[2] + s[3])) * (1.0f / 1024.0f) + RMS_EPS); }
__device__ __forceinline__ float sigmoid_f(float a) { return __builtin_amdgcn_rcpf(1.0f + __builtin_amdgcn_exp2f(-a * LOG2E)); }

struct EpiQKV0 {
    static constexpr bool PERM = true, AFTER_DRAIN = false;
    bf16_t* O; size_t tstride; const float* ssq; float qscale;
    __device__ __forceinline__ void operator()(const f32x4 (&acc)[2][2][4][2], const Unit& u, int wr, int wc, int fr, int fq) const {
        const int row0 = u.pm * BM + wr * 64 + fr; const int t = u.pn >> 2; bf16_t* base = O + (size_t)t * tstride;
        const float sc = (t == 0) ? qscale : 1.f; const int col0 = (u.pn & 3) * 256 + wc * 32 + 8 * fq;
#pragma unroll
        for (int ai = 0; ai < 2; ++ai)
#pragma unroll
            for (int m = 0; m < 4; ++m) { const int row = row0 + ai * HALF + m * 16; const float r = row_rinv(ssq, row) * sc; bf16_t* rowp = base + (size_t)row * 1024 + col0;
#pragma unroll
                for (int bj = 0; bj < 2; ++bj) { const f32x4 v0 = acc[ai][bj][m][0] * r, v1 = acc[ai][bj][m][1] * r;
                    u32x4 w; w.x = cvt_pk_bf16(v0[0], v0[1]); w.y = cvt_pk_bf16(v0[2], v0[3]); w.z = cvt_pk_bf16(v1[0], v1[1]); w.w = cvt_pk_bf16(v1[2], v1[3]);
                    *(u32x4*)(rowp + bj * HALF) = w; } }
    }
};
struct EpiKVQ1 {
    static constexpr bool PERM = true, AFTER_DRAIN = false;
    bf16_t* O; size_t tstride; const float* ssq; const float* gk; const float* gq; float qscale;
    __device__ __forceinline__ void operator()(const f32x4 (&acc)[2][2][4][2], const Unit& u, int wr, int wc, int fr, int fq) const {
        const int row0 = u.pm * BM + wr * 64 + fr; const int t = u.pn >> 2; bf16_t* base = O + (size_t)((t + 1) % 3) * tstride;
        const int head = (u.pn & 3) * 4 + wc;
        f32x4 gv[2][2];
        if (t != 1) { const float* g = (t == 0) ? gk : gq; const float s = (t == 0) ? 1.f : qscale;
#pragma unroll
            for (int bj = 0; bj < 2; ++bj)
#pragma unroll
                for (int n = 0; n < 2; ++n) gv[bj][n] = *(const f32x4*)(g + 32 * bj + 8 * fq + 4 * n) * s; }
#pragma unroll
        for (int ai = 0; ai < 2; ++ai)
#pragma unroll
            for (int m = 0; m < 4; ++m) { const int row = row0 + ai * HALF + m * 16; const float r = row_rinv(ssq, row);
                f32x4 v[2][2];
#pragma unroll
                for (int bj = 0; bj < 2; ++bj)
#pragma unroll
                    for (int n = 0; n < 2; ++n) v[bj][n] = acc[ai][bj][m][n] * r;
                if (t != 1) { float ss = 0.f;
#pragma unroll
                    for (int bj = 0; bj < 2; ++bj)
#pragma unroll
                        for (int n = 0; n < 2; ++n) { const f32x4 x = v[bj][n]; ss += (x[0] * x[0] + x[1] * x[1]) + (x[2] * x[2] + x[3] * x[3]); }
                    ss += __shfl_xor(ss, 16); ss += __shfl_xor(ss, 32);
                    const float rn = rsqrtf(ss * (1.0f / 64.0f) + RMS_EPS);
#pragma unroll
                    for (int bj = 0; bj < 2; ++bj)
#pragma unroll
                        for (int n = 0; n < 2; ++n) v[bj][n] = v[bj][n] * rn * gv[bj][n]; }
                bf16_t* rowp = base + (size_t)row * 1024 + head * 64 + 8 * fq;
#pragma unroll
                for (int bj = 0; bj < 2; ++bj) { const f32x4 v0 = v[bj][0], v1 = v[bj][1];
                    u32x4 w; w.x = cvt_pk_bf16(v0[0], v0[1]); w.y = cvt_pk_bf16(v0[2], v0[3]); w.z = cvt_pk_bf16(v1[0], v1[1]); w.w = cvt_pk_bf16(v1[2], v1[3]);
                    *(u32x4*)(rowp + 32 * bj) = w; } }
    }
};
struct EpiGU {
    static constexpr bool PERM = true, AFTER_DRAIN = false;
    bf16_t* O; const float* ssq;
    __device__ __forceinline__ void operator()(const f32x4 (&acc)[2][2][4][2], const Unit& u, int wr, int wc, int fr, int fq) const {
        const int row0 = u.pm * BM + wr * 64 + fr; const int col0 = u.pn * 128 + wc * 32 + 8 * fq;
#pragma unroll
        for (int ai = 0; ai < 2; ++ai)
#pragma unroll
            for (int m = 0; m < 4; ++m) { const int row = row0 + ai * HALF + m * 16; const float r = row_rinv(ssq, row); bf16_t* rowp = O + (size_t)row * 2816 + col0;
                f32x4 a[2];
#pragma unroll
                for (int n = 0; n < 2; ++n) { const f32x4 g = acc[ai][0][m][n] * r, uu = acc[ai][1][m][n] * r;
#pragma unroll
                    for (int i = 0; i < 4; ++i) a[n][i] = g[i] * sigmoid_f(g[i]) * uu[i]; }
                u32x4 w; w.x = cvt_pk_bf16(a[0][0], a[0][1]); w.y = cvt_pk_bf16(a[0][2], a[0][3]); w.z = cvt_pk_bf16(a[1][0], a[1][1]); w.w = cvt_pk_bf16(a[1][2], a[1][3]);
                *(u32x4*)rowp = w; }
    }
};
struct EpiProj {
    static constexpr bool PERM = false, AFTER_DRAIN = false;
    bf16_t* O;
    __device__ __forceinline__ void operator()(const f32x4 (&acc)[2][2][4][2], const Unit& u, int wr, int wc, int fr, int fq) const {
        const int row0 = u.pm * BM + wr * 64 + fr; const int col0 = u.pn * BM + wc * 32 + 4 * fq;
#pragma unroll
        for (int ai = 0; ai < 2; ++ai)
#pragma unroll
            for (int m = 0; m < 4; ++m) { bf16_t* rowp = O + (size_t)(row0 + ai * HALF + m * 16) * 1024 + col0;
#pragma unroll
                for (int bj = 0; bj < 2; ++bj)
#pragma unroll
                    for (int n = 0; n < 2; ++n) { const f32x4 v = acc[ai][bj][m][n]; u32x2 w; w.x = cvt_pk_bf16(v[0], v[1]); w.y = cvt_pk_bf16(v[2], v[3]); *(u32x2*)(rowp + bj * HALF + n * 16) = w; } }
    }
};
struct EpiRes {
    static constexpr bool PERM = false, AFTER_DRAIN = true;
    const float* base; float* out; bf16_t* hb; float* ssq_out;
    __device__ __forceinline__ void fused(const f32x4 (&acc)[2][2][4][2], const Unit& u, int wr, int wc, int fr, int fq, PG8_LAS unsigned char* lds, int wid, int lane) const {
        PG8_LAS float* P = (PG8_LAS float*)lds;
        const int col0 = u.pn * BM + wc * 32 + 4 * fq;
#pragma unroll
        for (int ai = 0; ai < 2; ++ai)
#pragma unroll
            for (int m = 0; m < 4; ++m) { const int r = ai * HALF + wr * 64 + m * 16 + fr; const size_t off = (size_t)(u.pm * BM + r) * 1024 + col0; float s = 0.f;
#pragma unroll
                for (int bj = 0; bj < 2; ++bj)
#pragma unroll
                    for (int n = 0; n < 2; ++n) { const f32x4 bs = *(const f32x4*)(base + off + bj * HALF + n * 16); const f32x4 v = bs + acc[ai][bj][m][n];
                        *(f32x4*)(out + off + bj * HALF + n * 16) = v; u32x2 w; w.x = cvt_pk_bf16(v[0], v[1]); w.y = cvt_pk_bf16(v[2], v[3]); *(u32x2*)(hb + off + bj * HALF + n * 16) = w;
                        s += (v[0] * v[0] + v[1] * v[1]) + (v[2] * v[2] + v[3] * v[3]); }
                s += __shfl_xor(s, 16); s += __shfl_xor(s, 32);
                if (fq == 0) P[r * 4 + wc] = s;
                if (m & 1) asm volatile("" ::: "memory"); }
        asm volatile("s_waitcnt lgkmcnt(0)" ::: "memory"); __builtin_amdgcn_s_barrier(); asm volatile("" ::: "memory");
        const int tid = wid * 64 + lane;
        if (tid < 256) { const f32x4 p = *(const PG8_LAS f32x4*)(P + tid * 4); ssq_out[(size_t)(u.pm * BM + tid) * 4 + u.pn] = (p[0] + p[1]) + (p[2] + p[3]); }
        asm volatile("s_waitcnt lgkmcnt(0)" ::: "memory"); __builtin_amdgcn_s_barrier(); asm volatile("" ::: "memory");
    }
};
struct EpiPle {
    static constexpr bool PERM = false, AFTER_DRAIN = true;
    const float* ssq_in; const bf16_t* projp; float* io; bf16_t* hb; float* ssq_out;
    __device__ __forceinline__ void fused(const f32x4 (&acc)[2][2][4][2], const Unit& u, int wr, int wc, int fr, int fq, PG8_LAS unsigned char* lds, int wid, int lane) const {
        PG8_LAS float* P = (PG8_LAS float*)lds;
        const int col0 = u.pn * BM + wc * 32 + 4 * fq;
#pragma unroll
        for (int ai = 0; ai < 2; ++ai)
#pragma unroll
            for (int m = 0; m < 4; ++m) { const int r = ai * HALF + wr * 64 + m * 16 + fr; const int row = u.pm * BM + r; const size_t off = (size_t)row * 1024 + col0; float s = 0.f;
                const float ri = row_rinv(ssq_in, row);
#pragma unroll
                for (int bj = 0; bj < 2; ++bj)
#pragma unroll
                    for (int n = 0; n < 2; ++n) { const size_t o2 = off + bj * HALF + n * 16; const f32x4 bs = *(const f32x4*)(io + o2); const u32x2 pw = *(const u32x2*)(projp + o2);
                        const f32x4 a = acc[ai][bj][m][n] * ri; f32x4 v;
                        v[0] = bs[0] + sigmoid_f(a[0]) * __uint_as_float(pw.x << 16); v[1] = bs[1] + sigmoid_f(a[1]) * __uint_as_float(pw.x & 0xffff0000u);
                        v[2] = bs[2] + sigmoid_f(a[2]) * __uint_as_float(pw.y << 16); v[3] = bs[3] + sigmoid_f(a[3]) * __uint_as_float(pw.y & 0xffff0000u);
                        *(f32x4*)(io + o2) = v;
                        if (hb) { u32x2 w; w.x = cvt_pk_bf16(v[0], v[1]); w.y = cvt_pk_bf16(v[2], v[3]); *(u32x2*)(hb + o2) = w; }
                        s += (v[0] * v[0] + v[1] * v[1]) + (v[2] * v[2] + v[3] * v[3]); }
                s += __shfl_xor(s, 16); s += __shfl_xor(s, 32);
                if (fq == 0) P[r * 4 + wc] = s;
                if (m & 1) asm volatile("" ::: "memory"); }
        asm volatile("s_waitcnt lgkmcnt(0)" ::: "memory"); __builtin_amdgcn_s_barrier(); asm volatile("" ::: "memory");
        const int tid = wid * 64 + lane;
        if (ssq_out && tid < 256) { const f32x4 p = *(const PG8_LAS f32x4*)(P + tid * 4); ssq_out[(size_t)(u.pm * BM + tid) * 4 + u.pn] = (p[0] + p[1]) + (p[2] + p[3]); }
        asm volatile("s_waitcnt lgkmcnt(0)" ::: "memory"); __builtin_amdgcn_s_barrier(); asm volatile("" ::: "memory");
    }
};
struct OneUnit {
    Unit u;
    __device__ __forceinline__ bool next(int i, Unit& o) const { if (i) return false; o = u; return true; }
    __device__ __forceinline__ void a_ready(const Unit&) const {}
    __device__ __forceinline__ void done(const Unit&) const {}
};

template <class Epi, class Sched, bool ALIGN_EPI = false, bool SP2 = false>
__device__ __forceinline__ void gemm_phase(PG8_LAS unsigned char* lds, const Gemm g, const Sched& S, const Epi& E) {
    int tid_ = threadIdx.x; asm volatile("" : "+v"(tid_));
    const int tid = tid_, wid = __builtin_amdgcn_readfirstlane(tid >> 6), lane = tid & 63, wr = wid >> 2, wc = wid & 3, fr = lane & 15, fq = lane >> 4;
    const int K = g.K, nt = K / BK;
    unsigned voffA[2], voffB[2];
#pragma unroll
    for (int i = 0; i < 2; ++i) { int R, C; stage_rc(tid * 16 + i * 8192, R, C); const int Rb = Epi::PERM ? ((R & ~31) + perm32(R & 31)) : R;
        voffA[i] = (unsigned)(R * K + C) * 2u; voffB[i] = (unsigned)(Rb * K + C) * 2u; }
    const size_t kstep = (size_t)(BK * 2);
    const size_t hstep = (size_t)HALF * K * 2;
    const size_t tstep = 2 * hstep;
    const unsigned ldsw = (unsigned)wid * 1024u;
    const int aoff = lds_byte(wr * 64 + fr, fq * 8), boff = lds_byte(wc * 32 + fr, fq * 8);
#define PG8_SA(b, h) (((b) * 2 + (h)) * HTB)
#define PG8_SB(b, h) ((4 + (b) * 2 + (h)) * HTB)
#define PG8_STAGE(bufoff, gbase, voff) do { _Pragma("unroll") for (int _i = 0; _i < 2; ++_i) \
        __builtin_amdgcn_global_load_lds((const unsigned*)((const char*)(gbase) + (voff)[_i]), (PG8_LAS unsigned*)(lds + (bufoff) + ldsw + _i * 8192), 16, 0, 0); } while (0)
#define PG8_LDA(dst, b, h) do { _Pragma("unroll") for (int m = 0; m < 4; ++m) _Pragma("unroll") for (int k = 0; k < 2; ++k) dst[m][k] = *(const PG8_LAS bf16x8*)(lds + PG8_SA(b, h) + aoff + m * 2048 + k * 1024); } while (0)
#define PG8_LDB(dst, b, h) do { _Pragma("unroll") for (int n = 0; n < 2; ++n) _Pragma("unroll") for (int k = 0; k < 2; ++k) dst[n][k] = *(const PG8_LAS bf16x8*)(lds + PG8_SB(b, h) + boff + n * 2048 + k * 1024); } while (0)
#define PG8_MMA(ai, bj, At, Bt) do { __builtin_amdgcn_s_setprio(1); _Pragma("unroll") for (int m = 0; m < 4; ++m) _Pragma("unroll") for (int n = 0; n < 2; ++n) _Pragma("unroll") for (int k = 0; k < 2; ++k) \
        acc[ai][bj][m][n] = __builtin_amdgcn_mfma_f32_16x16x32_bf16(Bt[n][k], At[m][k], acc[ai][bj][m][n], 0, 0, 0); __builtin_amdgcn_s_setprio(0); } while (0)
#define PG8_WAIT_V(n) asm volatile("s_waitcnt vmcnt(" #n ")" ::: "memory")
#define PG8_WAIT_L(n) asm volatile("s_waitcnt lgkmcnt(" #n ")" ::: "memory")
#define PG8_BAR __builtin_amdgcn_s_barrier()
#define PG8_SCHED __builtin_amdgcn_sched_barrier(0)
    Unit cur, nxt; int ui = 0;
    if (!S.next(0, cur)) return;
    f32x4 acc[2][2][4][2];
#pragma unroll
    for (int a = 0; a < 2; ++a)
#pragma unroll
        for (int b = 0; b < 2; ++b)
#pragma unroll
            for (int m = 0; m < 4; ++m)
#pragma unroll
                for (int n = 0; n < 2; ++n) acc[a][b][m][n] = (f32x4){0.f, 0.f, 0.f, 0.f};
    bf16x8 At[4][2], B0[2][2], B1[2][2];
    const char* cA = (const char*)g.A + (size_t)cur.pm * tstep; const char* cB = (const char*)g.Bt + (size_t)cur.pn * tstep;
    S.a_ready(cur);
    if constexpr (SP2) {
        PG8_STAGE(PG8_SB(0, 0), cB, voffB); PG8_STAGE(PG8_SB(0, 1), cB + hstep, voffB); PG8_STAGE(PG8_SA(0, 0), cA, voffA); PG8_STAGE(PG8_SA(0, 1), cA + hstep, voffA);
        if (wr == 1) PG8_BAR;
        PG8_WAIT_V(2); PG8_BAR;
        PG8_STAGE(PG8_SB(1, 0), cB + kstep, voffB); PG8_STAGE(PG8_SA(1, 0), cA + kstep, voffA); PG8_STAGE(PG8_SB(1, 1), cB + hstep + kstep, voffB);
        PG8_WAIT_V(6); PG8_BAR;
    } else {
        PG8_STAGE(PG8_SB(0, 0), cB, voffB); PG8_STAGE(PG8_SA(0, 0), cA, voffA); PG8_STAGE(PG8_SB(0, 1), cB + hstep, voffB); PG8_STAGE(PG8_SA(0, 1), cA + hstep, voffA);
        if (wr == 1) PG8_BAR;
        PG8_WAIT_V(4); PG8_BAR;
        PG8_STAGE(PG8_SB(1, 0), cB + kstep, voffB); PG8_STAGE(PG8_SA(1, 0), cA + kstep, voffA); PG8_STAGE(PG8_SB(1, 1), cB + hstep + kstep, voffB);
        PG8_WAIT_V(6); PG8_BAR;
    }
    for (;;) {
        const bool has_next = S.next(ui + 1, nxt);
        const char* nA = has_next ? (const char*)g.A + (size_t)nxt.pm * tstep : cA; const char* nB = has_next ? (const char*)g.Bt + (size_t)nxt.pn * tstep : cB;
        for (int t = 0; t < nt; t += 2) {
            const bool last = (t == nt - 2);
            const char* a1 = cA + (size_t)(t + 1) * kstep;
            const char* a2 = last ? nA : cA + (size_t)(t + 2) * kstep; const char* b2 = last ? nB : cB + (size_t)(t + 2) * kstep;
            const char* a3 = a2 + kstep; const char* b3 = b2 + kstep;
            if (last && has_next) S.a_ready(nxt);
            if constexpr (SP2) {
            PG8_LDB(B0, 0, 0); PG8_LDB(B1, 0, 1); PG8_SCHED; PG8_LDA(At, 0, 0); PG8_STAGE(PG8_SA(1, 1), a1 + hstep, voffA);
            PG8_WAIT_V(8); PG8_WAIT_L(0); PG8_BAR; PG8_MMA(0, 0, At, B0); PG8_MMA(0, 1, At, B1); PG8_BAR; PG8_SCHED;
            PG8_LDA(At, 0, 1); PG8_STAGE(PG8_SB(0, 0), b2, voffB); PG8_STAGE(PG8_SB(0, 1), b2 + hstep, voffB); PG8_STAGE(PG8_SA(0, 0), a2, voffA);
            PG8_WAIT_V(8); PG8_WAIT_L(0); PG8_BAR; PG8_MMA(1, 0, At, B0); PG8_MMA(1, 1, At, B1); PG8_BAR; PG8_SCHED;
            PG8_LDB(B0, 1, 0); PG8_LDB(B1, 1, 1); PG8_SCHED; PG8_LDA(At, 1, 0); PG8_STAGE(PG8_SA(0, 1), a2 + hstep, voffA);
            PG8_WAIT_V(8); PG8_WAIT_L(0); PG8_BAR; PG8_MMA(0, 0, At, B0); PG8_MMA(0, 1, At, B1); PG8_BAR; PG8_SCHED;
            PG8_LDA(At, 1, 1); PG8_STAGE(PG8_SB(1, 0), b3, voffB); PG8_STAGE(PG8_SB(1, 1), b3 + hstep, voffB); PG8_STAGE(PG8_SA(1, 0), a3, voffA);
            PG8_WAIT_V(8); PG8_WAIT_L(0); PG8_BAR; PG8_MMA(1, 0, At, B0); PG8_MMA(1, 1, At, B1); PG8_BAR; PG8_SCHED;
            } else {
            PG8_LDB(B0, 0, 0); PG8_SCHED; PG8_LDA(At, 0, 0); PG8_STAGE(PG8_SA(1, 1), a1 + hstep, voffA);
            PG8_WAIT_L(8); PG8_BAR; PG8_WAIT_L(0); PG8_MMA(0, 0, At, B0); PG8_BAR; PG8_SCHED;
            PG8_LDB(B1, 0, 1); PG8_STAGE(PG8_SB(0, 0), b2, voffB);
            PG8_BAR; PG8_WAIT_L(0); PG8_MMA(0, 1, At, B1); PG8_BAR;
            PG8_LDA(At, 0, 1); PG8_STAGE(PG8_SA(0, 0), a2, voffA);
            PG8_BAR; PG8_WAIT_L(0); PG8_MMA(1, 0, At, B0); PG8_BAR; PG8_SCHED;
            PG8_STAGE(PG8_SB(0, 1), b2 + hstep, voffB);
            PG8_WAIT_V(6); PG8_BAR; PG8_MMA(1, 1, At, B1); PG8_BAR;
            PG8_LDB(B0, 1, 0); PG8_SCHED; PG8_LDA(At, 1, 0); PG8_STAGE(PG8_SA(0, 1), a2 + hstep, voffA);
            PG8_WAIT_L(8); PG8_BAR; PG8_WAIT_L(0); PG8_MMA(0, 0, At, B0); PG8_BAR; PG8_SCHED;
            PG8_LDB(B1, 1, 1); PG8_STAGE(PG8_SB(1, 0), b3, voffB);
            PG8_BAR; PG8_WAIT_L(0); PG8_MMA(0, 1, At, B1); PG8_BAR;
            PG8_LDA(At, 1, 1); PG8_STAGE(PG8_SA(1, 0), a3, voffA);
            PG8_BAR; PG8_WAIT_L(0); PG8_MMA(1, 0, At, B0); PG8_BAR; PG8_SCHED;
            PG8_STAGE(PG8_SB(1, 1), b3 + hstep, voffB);
            PG8_WAIT_V(6); PG8_BAR; PG8_MMA(1, 1, At, B1); PG8_BAR;
            }
        }
        if constexpr (ALIGN_EPI) { if (wr == 0) PG8_BAR; }
        if constexpr (!Epi::AFTER_DRAIN) { E(acc, cur, wr, wc, fr, fq); S.done(cur); }
        if (!has_next) break;
#pragma unroll
        for (int a = 0; a < 2; ++a)
#pragma unroll
            for (int b = 0; b < 2; ++b)
#pragma unroll
                for (int m = 0; m < 4; ++m)
#pragma unroll
                    for (int n = 0; n < 2; ++n) acc[a][b][m][n] = (f32x4){0.f, 0.f, 0.f, 0.f};
        cur = nxt; cA = nA; cB = nB; ++ui;
        if constexpr (ALIGN_EPI) { if (wr == 1) PG8_BAR; }
    }
    PG8_WAIT_V(0);
    if constexpr (!ALIGN_EPI) { if (wr == 0) PG8_BAR; }
    PG8_BAR;
    if constexpr (Epi::AFTER_DRAIN) { E.fused(acc, cur, wr, wc, fr, fq, lds, wid, lane); S.done(cur); }
#undef PG8_SA
#undef PG8_SB
#undef PG8_STAGE
#undef PG8_LDA
#undef PG8_LDB
#undef PG8_MMA
#undef PG8_WAIT_V
#undef PG8_WAIT_L
#undef PG8_BAR
#undef PG8_SCHED
}
}

constexpr int M = 16384, D = 1024, NH = 16, DH = 64, FF = 2816, PLE = 256;
constexpr float LOG2E_F = 1.4426950408889634f;
constexpr float QSCALE = 0.125f * LOG2E_F;
constexpr float THR2 = 160.0f;
constexpr int NWAVES = 8;

#define GAS __attribute__((address_space(1)))
#define LAS __attribute__((address_space(3)))
typedef unsigned short bf16;
typedef unsigned v4u __attribute__((ext_vector_type(4)));
typedef unsigned v2u __attribute__((ext_vector_type(2)));
typedef float f32x4 __attribute__((ext_vector_type(4)));
typedef float f32x16 __attribute__((ext_vector_type(16)));
typedef short bf16x8 __attribute__((ext_vector_type(8)));
typedef short s16x4 __attribute__((ext_vector_type(4)));
#define RLX_AGENT __ATOMIC_RELAXED, __HIP_MEMORY_SCOPE_AGENT
#define LDS_WAIT() asm volatile("s_waitcnt lgkmcnt(0)" ::: "memory")
__device__ __forceinline__ unsigned f2bf(float f) { unsigned u = __builtin_bit_cast(unsigned, f); return (u + 0x7fffu + ((u >> 16) & 1u)) >> 16; }
__device__ __forceinline__ unsigned pk2(float lo, float hi) { return f2bf(lo) | (f2bf(hi) << 16); }
__device__ __forceinline__ unsigned cvtpk(float lo, float hi) { unsigned r; asm volatile("v_cvt_pk_bf16_f32 %0, %1, %2" : "=v"(r) : "v"(lo), "v"(hi)); return r; }
__device__ __forceinline__ float ex2(float x) { return __builtin_amdgcn_exp2f(x); }
__device__ __forceinline__ float lg2(float x) { return __builtin_amdgcn_logf(x); }

constexpr size_t MiB = 1u << 20;
constexpr size_t WS_CTL = 0, CTL_ZERO_BYTES = 64 * 1024;
constexpr size_t WS_SSQ = 1 * MiB;
constexpr size_t WS_WF = 1 * MiB + 6 * 256 * 1024;
constexpr size_t WS_LS2 = 3 * MiB;
constexpr size_t WS_WQKV0 = 4 * MiB, WS_WO0 = 10 * MiB, WS_WKVQ1 = 12 * MiB, WS_WO1 = 18 * MiB, WS_WGU = 20 * MiB  , WS_WD = 42 * MiB  , WS_WG = 53 * MiB  , WS_WP = 57 * MiB  ;
constexpr size_t WS_HBA = 58 * MiB, WS_HBB = 90 * MiB, WS_Q = 122 * MiB, WS_K = 154 * MiB, WS_V = 186 * MiB, WS_ACT = 122 * MiB  , WS_PBUF = 210 * MiB  , WS_PROJ = 218 * MiB, WS_END = 250 * MiB;
constexpr int CW_BAR = 1024;

constexpr int RING_BYTES = 131072, MISC_OFF = RING_BYTES + 320, LDS_BYTES = 147456;

#define XB_TMO      128
#define XB_XCNT(j)  (256  + 64 * (j))
#define XB_XSUB(j)  (1280 + 64 * (j))
#define XB_XGEN(j)  (2304 + 64 * (j))
#define XB_TOP      3328
#define XB_TOPGEN   3392
#define XCD_BAR_WORDS 3456
#define XB_SPIN_CAP (1u << 18)

__device__ __forceinline__ unsigned xb_ld(unsigned* p)              { return __hip_atomic_load(p, __ATOMIC_RELAXED, __HIP_MEMORY_SCOPE_AGENT); }
__device__ __forceinline__ unsigned xb_add(unsigned* p, unsigned v) { return __hip_atomic_fetch_add(p, v, __ATOMIC_RELAXED, __HIP_MEMORY_SCOPE_AGENT); }
__device__ __forceinline__ unsigned xb_xcc_id() { return (unsigned)__builtin_amdgcn_s_getreg((3 << 11) | 20) & 0xFu; }
#define XB_SPIN(cond, bar) do { unsigned _sp = 0; while (cond) { __builtin_amdgcn_s_sleep(1); \
    if ((++_sp & 255u) == 0u) { if (xb_ld(&(bar)[XB_TMO])) break; if (_sp > XB_SPIN_CAP) { atomicAdd(&(bar)[XB_TMO], 1u); break; } } } } while (0)

struct XcdBarrier {
    unsigned* bar; unsigned x;
    volatile LAS unsigned* st;
};

__device__ __forceinline__ XcdBarrier xcd_barrier_post(unsigned* bar, volatile LAS unsigned* st) {
    XcdBarrier b; b.bar = bar; b.x = xb_xcc_id(); b.st = st;
    if (threadIdx.x == 0) (void)xb_add(&bar[XB_XCNT(b.x)], 1u);
    return b;
}
__device__ __forceinline__ void xcd_barrier_complete(unsigned* bar, unsigned x, unsigned& nloc, unsigned& nx) {
    const unsigned G = gridDim.x * gridDim.y * gridDim.z;
    unsigned sum, cnt, mine, sp = 0u;
    for (;;) {
        sum = 0u; cnt = 0u; mine = 0u;
#pragma unroll
        for (unsigned j = 0; j < 16; ++j) { const unsigned c = xb_ld(&bar[XB_XCNT(j)]); sum += c; cnt += (c > 0u) ? 1u : 0u; mine = (j == x) ? c : mine; }
        if (sum == G) break;
        __builtin_amdgcn_s_sleep(1);
        if ((++sp & 255u) == 0u) { if (xb_ld(&bar[XB_TMO])) break; if (sp > XB_SPIN_CAP) { atomicAdd(&bar[XB_TMO], 1u); break; } }
    }
    nloc = mine > 0u ? mine : 1u; nx = cnt > 0u ? cnt : 1u;
}

__device__ __forceinline__ void xcd_barrier(const XcdBarrier& b) {
    asm volatile("s_waitcnt vmcnt(0)" ::: "memory");
    __syncthreads();
    if (threadIdx.x == 0) {
        unsigned* bar = b.bar;
        __builtin_amdgcn_s_waitcnt(0);
        unsigned nloc = b.st[0], nx = b.st[1];
        if (nloc == 0u) { xcd_barrier_complete(bar, b.x, nloc, nx); b.st[0] = nloc; b.st[1] = nx; }
        const unsigned old = xb_add(&bar[XB_XSUB(b.x)], 1u);
        const unsigned gen = old / nloc;
        if (old + 1u == (gen + 1u) * nloc) {
            __builtin_amdgcn_fence(__ATOMIC_RELEASE, "agent");
            asm volatile("s_waitcnt vmcnt(0)" ::: "memory");
            const unsigned og = xb_add(&bar[XB_TOP], 1u);
            const unsigned tg = og / nx;
            if (og + 1u == (tg + 1u) * nx) xb_add(&bar[XB_TOPGEN], 1u);
            else XB_SPIN(xb_ld(&bar[XB_TOPGEN]) == tg, bar);
            __builtin_amdgcn_fence(__ATOMIC_ACQUIRE, "agent");
            xb_add(&bar[XB_XGEN(b.x)], 1u);
            asm volatile("s_waitcnt vmcnt(0)" ::: "memory");
        } else {
            XB_SPIN(xb_ld(&bar[XB_XGEN(b.x)]) == gen, bar);
            __builtin_amdgcn_fence(__ATOMIC_ACQUIRE, "agent");
            asm volatile("s_waitcnt vmcnt(0)" ::: "memory");
        }
    }
    __syncthreads();
}

namespace att {
constexpr int KPITCH = 144, BUF_BYTES = 2 * 64 * KPITCH, GK_OFF = 2 * BUF_BYTES, GQ_OFF = GK_OFF + 2 * 256, FLAG_OFF = GQ_OFF + 1024;
#define MFMA32(a, b, c) __builtin_amdgcn_mfma_f32_32x32x16_bf16((a), (b), (c), 0, 0, 0)
__device__ __forceinline__ void swap_halves(float v, float& lo, float& hi_) { auto rr = __builtin_amdgcn_permlane32_swap(__float_as_uint(v), __float_as_uint(v), false, false); lo = __uint_as_float(rr[0]); hi_ = __uint_as_float(rr[1]); }

struct Stage { v4u k, v; };
__device__ __forceinline__ void stage_load(Stage& s, const bf16* Kg, const bf16* Vg, int h, int j, int tid) {
    const int k_kv = tid >> 3, k_ch = tid & 7, v_kv = tid & 63, v_ch = tid >> 6;
    s.k = *(const v4u*)(Kg + (size_t)(64 * j + k_kv) * D + h * DH + k_ch * 8);
    s.v = *(const v4u*)(Vg + (size_t)(64 * j + v_kv) * D + h * DH + v_ch * 8);
}
__device__ __forceinline__ void stage_store(const Stage& s, LAS unsigned char* buf, int tid) {
    const int k_kv = tid >> 3, k_ch = tid & 7, v_kv = tid & 63, v_ch = tid >> 6;
    *(LAS v4u*)(buf + k_kv * KPITCH + k_ch * 16) = s.k;
    LAS unsigned short* vt = (LAS unsigned short*)(buf + 64 * KPITCH) + v_kv;
    const unsigned w[4] = {s.v.x, s.v.y, s.v.z, s.v.w};
#pragma unroll
    for (int i = 0; i < 4; ++i) { vt[(v_ch * 8 + 2 * i) * (KPITCH / 2)] = (unsigned short)(w[i] & 0xffffu); vt[(v_ch * 8 + 2 * i + 1) * (KPITCH / 2)] = (unsigned short)(w[i] >> 16); }
}
__device__ __forceinline__ void qk_tile(f32x16& S0, f32x16& S1, const LAS unsigned char* buf, const bf16x8 (&qf)[4], int r32, int hi) {
    const LAS unsigned char* kb = buf + r32 * KPITCH + hi * 16;
#pragma unroll
    for (int d0 = 0; d0 < 4; ++d0) { const bf16x8 a0 = *(const LAS bf16x8*)(kb + d0 * 32), a1 = *(const LAS bf16x8*)(kb + 32 * KPITCH + d0 * 32);
        S0 = MFMA32(a0, qf[d0], S0); S1 = MFMA32(a1, qf[d0], S1); }
}
__device__ __forceinline__ void pv_tile(f32x16& o0, f32x16& o1, const LAS unsigned char* buf, const float (&pw)[32], int r32, int hi) {
    const LAS unsigned char* vt = buf + 64 * KPITCH + r32 * KPITCH + hi * 8;
#pragma unroll
    for (int p = 0; p < 2; ++p)
#pragma unroll
        for (int s = 0; s < 2; ++s) { const int o = p * 16 + 8 * s;
            v4u pk; pk.x = cvtpk(pw[o], pw[o + 1]); pk.y = cvtpk(pw[o + 2], pw[o + 3]); pk.z = cvtpk(pw[o + 4], pw[o + 5]); pk.w = cvtpk(pw[o + 6], pw[o + 7]);
            const bf16x8 pb = __builtin_bit_cast(bf16x8, pk);
            const int kb = (32 * p + 16 * s) * 2;
            const s16x4 l0 = *(const LAS s16x4*)(vt + kb), h0 = *(const LAS s16x4*)(vt + kb + 16);
            const s16x4 l1 = *(const LAS s16x4*)(vt + 32 * KPITCH + kb), h1 = *(const LAS s16x4*)(vt + 32 * KPITCH + kb + 16);
            const bf16x8 a0 = __builtin_shufflevector(l0, h0, 0, 1, 2, 3, 4, 5, 6, 7), a1 = __builtin_shufflevector(l1, h1, 0, 1, 2, 3, 4, 5, 6, 7);
            o0 = MFMA32(a0, pb, o0); o1 = MFMA32(a1, pb, o1); }
}
__device__ __forceinline__ void store_o(bf16* Og, int tq, int h, const f32x16& o0, const f32x16& o1, float sc, int hi) {
    bf16* op = Og + (size_t)tq * D + h * DH + 4 * hi;
#pragma unroll
    for (int g = 0; g < 4; ++g) { v2u w0, w1; w0.x = cvtpk(o0[4 * g] * sc, o0[4 * g + 1] * sc); w0.y = cvtpk(o0[4 * g + 2] * sc, o0[4 * g + 3] * sc);
        w1.x = cvtpk(o1[4 * g] * sc, o1[4 * g + 1] * sc); w1.y = cvtpk(o1[4 * g + 2] * sc, o1[4 * g + 3] * sc);
        *(v2u*)(op + 8 * g) = w0; *(v2u*)(op + 32 + 8 * g) = w1; }
}

__device__ __forceinline__ void sb_unit(int h, int qb, const bf16* Qg, const bf16* Kg, const bf16* Vg, bf16* Og, LAS unsigned char* lds) {
    int tid_ = threadIdx.x; asm volatile("" : "+v"(tid_));
    const int tid = tid_, lane = tid & 63, r32 = lane & 31, hi = lane >> 5, wid = __builtin_amdgcn_readfirstlane(tid >> 6);
    const int q0 = qb * 256, t0w = q0 + wid * 32, tq = t0w + r32, jmax = 4 * qb + 3;
    volatile LAS int* flags = (volatile LAS int*)(lds + FLAG_OFF);
    __syncthreads();
    if (tid < 16) flags[tid] = 0;
    bf16x8 qf[4];
#pragma unroll
    for (int d0 = 0; d0 < 4; ++d0) qf[d0] = *(const bf16x8*)(Qg + (size_t)tq * D + h * DH + d0 * 16 + hi * 8);
    f32x16 o0 = {}, o1 = {}; float carry = 0.f; bool wdone = false;
    Stage st; stage_load(st, Kg, Vg, h, jmax, tid); stage_store(st, lds, tid);
    __syncthreads();
    for (int j = jmax, it = 0;; --j, ++it) {
        const int b = it & 1; LAS unsigned char* buf = lds + b * BUF_BYTES;
        if (it > 0) { int nd = 0;
#pragma unroll
            for (int w = 0; w < 8; ++w) nd += flags[((it - 1) & 1) * 8 + w];
            if (nd == 8) break; }
        const bool have_next = j > 0;
        if (have_next) stage_load(st, Kg, Vg, h, j - 1, tid);
        if (!wdone && 64 * j <= t0w) {
            f32x16 S0 = {}, S1 = {};
            qk_tile(S0, S1, buf, qf, r32, hi);
            const bool need_mask = 64 * j + 63 >= t0w;
            float ls[32], lgb[32];
#pragma unroll
            for (int p = 0; p < 2; ++p)
#pragma unroll
                for (int i = 0; i < 16; ++i) { const float z = p ? S1[i] : S0[i];
                    const float sp = fmaxf(z, 0.f) + lg2(1.f + ex2(-fabsf(z)));
                    const int kv = 64 * j + 32 * p + (i & 3) + 8 * (i >> 2) + 4 * hi;
                    const bool ok = !need_mask || (kv < tq);
                    ls[p * 16 + i] = ok ? -sp : 0.f; lgb[p * 16 + i] = ok ? (z - sp) : -INFINITY; }
            float base = carry;
#pragma unroll
            for (int p = 1; p >= 0; --p)
#pragma unroll
                for (int g = 3; g >= 0; --g) { const int o = p * 16 + 4 * g;
                    const float s3 = ls[o + 3], s2 = s3 + ls[o + 2], s1 = s2 + ls[o + 1], G = s1 + ls[o];
                    float Glo, Ghi; swap_halves(G, Glo, Ghi);
                    const float bl = base + (hi ? 0.f : Ghi);
                    lgb[o + 3] = ex2(lgb[o + 3] + bl); lgb[o + 2] = ex2(lgb[o + 2] + (bl + s3)); lgb[o + 1] = ex2(lgb[o + 1] + (bl + s2)); lgb[o] = ex2(lgb[o] + (bl + s1));
                    base += Glo + Ghi; }
            carry = base;
            pv_tile(o0, o1, buf, lgb, r32, hi);
            wdone = __all(carry < -THR2);
        }
        if (lane == 0) flags[b * 8 + wid] = wdone ? 1 : 0;
        if (have_next) stage_store(st, lds + (b ^ 1) * BUF_BYTES, tid);
        __syncthreads();
        if (!have_next) break;
    }
    store_o(Og, tq, h, o0, o1, 1.f, hi);
}

__device__ __forceinline__ float suffix_scan_excl(float v, int lane, float& total) {
    float inc = v;
#pragma unroll
    for (int off = 1; off < 64; off <<= 1) { const float t = __shfl_down(inc, off); if (lane + off < 64) inc += t; }
    total = __shfl(inc, 0); return inc - v;
}
__device__ __forceinline__ void fox_unit(int h, int qb, const bf16* Qg, const bf16* Kg, const bf16* Vg, bf16* Og, const float* LS2, float bound2, LAS unsigned char* lds) {
    int tid_ = threadIdx.x; asm volatile("" : "+v"(tid_));
    const int tid = tid_, lane = tid & 63, r32 = lane & 31, hi = lane >> 5, wid = __builtin_amdgcn_readfirstlane(tid >> 6);
    const int q0 = qb * 256, t0w = q0 + wid * 32, tq = t0w + r32, jmax = 4 * qb + 3;
    volatile LAS int* flags = (volatile LAS int*)(lds + FLAG_OFF);
    LAS float* GK = (LAS float*)(lds + GK_OFF); LAS float* GQ = (LAS float*)(lds + GQ_OFF);
    const float* lsh = LS2 + (size_t)h * M;
    __syncthreads();
    if (tid < 16) flags[tid] = 0;
    float cgk = 0.f;
    if (wid == 0) { float c = 0.f;
        for (int jj = jmax; jj > jmax - 4; --jj) { float tot; const float ex = suffix_scan_excl(lsh[64 * jj + lane], lane, tot); GQ[(jj - 4 * qb) * 64 + lane] = c + ex; c += tot; }
        float tot; const float ex = suffix_scan_excl(lsh[64 * jmax + lane], lane, tot); GK[lane] = ex; cgk = tot; }
    bf16x8 qf[4];
#pragma unroll
    for (int d0 = 0; d0 < 4; ++d0) qf[d0] = *(const bf16x8*)(Qg + (size_t)tq * D + h * DH + d0 * 16 + hi * 8);
    f32x16 o0 = {}, o1 = {}; float mrun = -INFINITY, lsum = 0.f; bool wdone = false;
    Stage st; stage_load(st, Kg, Vg, h, jmax, tid); stage_store(st, lds, tid);
    __syncthreads();
    const float gq = GQ[wid * 32 + r32], gq0 = GQ[wid * 32];
    for (int j = jmax, it = 0;; --j, ++it) {
        const int b = it & 1; LAS unsigned char* buf = lds + b * BUF_BYTES; const LAS float* gkb = GK + b * 64;
        if (it > 0) { int nd = 0;
#pragma unroll
            for (int w = 0; w < 8; ++w) nd += flags[((it - 1) & 1) * 8 + w];
            if (nd == 8) break; }
        const bool have_next = j > 0;
        float gnext = 0.f;
        if (have_next) { stage_load(st, Kg, Vg, h, j - 1, tid); if (wid == 0) gnext = lsh[64 * (j - 1) + lane]; }
        if (!wdone && 64 * j <= t0w) {
            if (gkb[63] - gq0 + bound2 < -THR2) wdone = true;
            else {
                f32x16 S0 = {}, S1 = {};
                qk_tile(S0, S1, buf, qf, r32, hi);
                const bool need_mask = 64 * j + 63 > t0w;
                float x[32]; float tmax = -INFINITY;
#pragma unroll
                for (int p = 0; p < 2; ++p)
#pragma unroll
                    for (int g = 0; g < 4; ++g) { const f32x4 gk4 = *(const LAS f32x4*)(gkb + 32 * p + 8 * g + 4 * hi);
#pragma unroll
                        for (int e = 0; e < 4; ++e) { const int i = 4 * g + e; const float z = p ? S1[i] : S0[i];
                            const int kv = 64 * j + 32 * p + 8 * g + 4 * hi + e;
                            float v = z + (gk4[e] - gq);
                            if (need_mask && kv > tq) v = -INFINITY;
                            x[p * 16 + i] = v; tmax = fmaxf(tmax, v); } }
                float tl, th; swap_halves(tmax, tl, th); tmax = fmaxf(tl, th);
                const float mnew = fmaxf(mrun, tmax), alpha = ex2(mrun - mnew); mrun = mnew;
                float ps = 0.f;
#pragma unroll
                for (int i = 0; i < 32; ++i) { x[i] = ex2(x[i] - mnew); ps += x[i]; }
                lsum = lsum * alpha + ps;
#pragma unroll
                for (int i = 0; i < 16; ++i) { o0[i] *= alpha; o1[i] *= alpha; }
                pv_tile(o0, o1, buf, x, r32, hi);
            }
        }
        if (lane == 0) flags[b * 8 + wid] = wdone ? 1 : 0;
        if (have_next) { stage_store(st, lds + (b ^ 1) * BUF_BYTES, tid);
            if (wid == 0) { float tot; const float ex = suffix_scan_excl(gnext, lane, tot); GK[(b ^ 1) * 64 + lane] = cgk + ex; cgk += tot; } }
        __syncthreads();
        if (!have_next) break;
    }
    float ll, lh; swap_halves(lsum, ll, lh);
    store_o(Og, tq, h, o0, o1, __builtin_amdgcn_rcpf(ll + lh), hi);
}
#undef MFMA32
}

struct Frame { LAS unsigned char* lds; int tid, lane, wave, vcu, G; };
__device__ __forceinline__ float wave_sum(float v) {
#pragma unroll
    for (int o = 1; o < 64; o <<= 1) v += __shfl_xor(v, o);
    return v;
}
__device__ __forceinline__ float wave_max(float v) {
#pragma unroll
    for (int o = 1; o < 64; o <<= 1) v = fmaxf(v, __shfl_xor(v, o));
    return v;
}
template <int MAP> __device__ __forceinline__ void tr_item(const float* W, int K, int ldw, int csrc0, int nblk, const float* gain, bf16* WT, LAS float* scr, int item, int lane) {
    const int kb = item / nblk, nb = item % nblk, k0 = 64 * kb, n0 = 32 * nb;
    int v0;
    if (MAP == 0) v0 = n0;
    else if (MAP == 1) { const int head = n0 >> 6, bj = (n0 >> 5) & 1; v0 = 256 * (head >> 2) + 128 * bj + 32 * (head & 3); }
    else { const int isu = n0 >= FF, c = isu ? n0 - FF : n0; v0 = 256 * (c >> 7) + 128 * isu + (c & 127); }
#pragma unroll 8
    for (int i = 0; i < 32; ++i) { const int kk = 2 * i + (lane >> 5); float w = W[(size_t)(k0 + kk) * ldw + csrc0 + n0 + (lane & 31)]; if (gain) w *= gain[k0 + kk]; scr[kk * 33 + (lane & 31)] = w; }
    LDS_WAIT(); asm volatile("" ::: "memory");
    const int c = lane & 7;
#pragma unroll
    for (int j = 0; j < 4; ++j) { const int n = (lane >> 3) + 8 * j; const LAS float* s = scr + (8 * c) * 33 + n;
        v4u o; o.x = pk2(s[0 * 33], s[1 * 33]); o.y = pk2(s[2 * 33], s[3 * 33]); o.z = pk2(s[4 * 33], s[5 * 33]); o.w = pk2(s[6 * 33], s[7 * 33]);
        *(v4u*)(WT + (size_t)(v0 + n) * K + k0 + 8 * c) = o; }
    LDS_WAIT(); asm volatile("" ::: "memory");
}


struct Args { const float* in[18]; float* out; unsigned char* ws; };
typedef const __attribute__((address_space(4))) Args* ArgsP;
__device__ __forceinline__ ArgsP argp() { ArgsP p = (ArgsP)__builtin_amdgcn_kernarg_segment_ptr(); asm volatile("" : "+s"(p)); return p; }
#define WSP(T, off) ((T*)(A->ws + (off)))
enum { IN_X = 0, IN_P, IN_ATTN_G, IN_SB_WQKV, IN_SB_WO, IN_SHARED_G, IN_WKVF, IN_BF, IN_KNORM_G, IN_FOX_WQ, IN_QNORM_G, IN_FOX_WO, IN_FFN_G, IN_WGU, IN_WD, IN_PLE_G, IN_WGATE, IN_WPROJ };

__device__ __forceinline__ void convert_p(const Frame& F, const float* psrc, bf16* pdst) {
    const int gw = F.vcu * NWAVES + F.wave, NGW = F.G * NWAVES; const f32x4* ps = (const f32x4*)psrc; v2u* pd = (v2u*)pdst;
    for (int i = gw * 64 + F.lane; i < M * PLE / 4; i += NGW * 64) { const f32x4 v = ps[i]; v2u w; w.x = pk2(v.x, v.y); w.y = pk2(v.z, v.w); pd[i] = w; }
}

__device__ __forceinline__ void prologue(const Frame& F) {
    ArgsP A = argp();
    LAS float* scr = (LAS float*)(F.lds + F.wave * 16384);
    const int gw = F.vcu * NWAVES + F.wave, NGW = F.G * NWAVES;
    constexpr int I0 = 16 * 96, I1 = 512, I2 = 512, I3 = 512, I4 = 512, I5 = 512, I6 = 16 * 176, I7 = 44 * 32, I8 = 512, I9 = 4 * 32;
    constexpr int NITEMS = I0 + I1 + I2 + I3 + I4 + I5 + 2 * I6 + 2 * I7 + 2 * I8 + 2 * I9;
    for (int it = gw; it < NITEMS; it += NGW) {
        int r = it;
        if (r < I0) { tr_item<0>(A->in[IN_SB_WQKV], D, 3 * D, 0, 96, A->in[IN_ATTN_G], WSP(bf16, WS_WQKV0), scr, r, F.lane); continue; } r -= I0;
        if (r < I1) { tr_item<0>(A->in[IN_SB_WO], D, D, 0, 32, nullptr, WSP(bf16, WS_WO0), scr, r, F.lane); continue; } r -= I1;
        if (r < I2) { tr_item<1>(A->in[IN_WKVF], D, 2 * D + NH, 0, 32, A->in[IN_SHARED_G], WSP(bf16, WS_WKVQ1), scr, r, F.lane); continue; } r -= I2;
        if (r < I3) { tr_item<1>(A->in[IN_WKVF], D, 2 * D + NH, D, 32, A->in[IN_SHARED_G], WSP(bf16, WS_WKVQ1) + (size_t)D * D, scr, r, F.lane); continue; } r -= I3;
        if (r < I4) { tr_item<1>(A->in[IN_FOX_WQ], D, D, 0, 32, A->in[IN_ATTN_G] + D, WSP(bf16, WS_WKVQ1) + (size_t)2 * D * D, scr, r, F.lane); continue; } r -= I4;
        if (r < I5) { tr_item<0>(A->in[IN_FOX_WO], D, D, 0, 32, nullptr, WSP(bf16, WS_WO1), scr, r, F.lane); continue; } r -= I5;
        if (r < 2 * I6) { const int l = r / I6; tr_item<2>(A->in[IN_WGU] + (size_t)l * D * 2 * FF, D, 2 * FF, 0, 176, A->in[IN_FFN_G] + l * D, WSP(bf16, WS_WGU) + (size_t)l * 2 * FF * D, scr, r % I6, F.lane); continue; } r -= 2 * I6;
        if (r < 2 * I7) { const int l = r / I7; tr_item<0>(A->in[IN_WD] + (size_t)l * FF * D, FF, D, 0, 32, nullptr, WSP(bf16, WS_WD) + (size_t)l * D * FF, scr, r % I7, F.lane); continue; } r -= 2 * I7;
        if (r < 2 * I8) { const int l = r / I8; tr_item<0>(A->in[IN_WGATE] + (size_t)l * D * D, D, D, 0, 32, A->in[IN_PLE_G] + l * D, WSP(bf16, WS_WG) + (size_t)l * D * D, scr, r % I8, F.lane); continue; } r -= 2 * I8;
        { const int l = r / I9; tr_item<0>(A->in[IN_WPROJ] + (size_t)l * PLE * D, PLE, D, 0, 32, nullptr, WSP(bf16, WS_WP) + (size_t)l * D * PLE, scr, r % I9, F.lane); }
    }
    { const float* wk = A->in[IN_WKVF]; const float* sg = A->in[IN_SHARED_G]; bf16* WF = WSP(bf16, WS_WF);
      for (int i = gw * 64 + F.lane; i < NH * D; i += NGW * 64) { const int n = i >> 10, k = i & 1023; WF[i] = (bf16)f2bf(wk[(size_t)k * (2 * D + NH) + 2 * D + n] * sg[k]); } }
    { const float* x = A->in[IN_X]; bf16* HBA = WSP(bf16, WS_HBA); float* SSQ = WSP(float, WS_SSQ);
      for (int m = gw; m < M; m += NGW) {
        const f32x4* xr = (const f32x4*)(x + (size_t)m * D) + F.lane; f32x4 v[4]; float s = 0.f;
#pragma unroll
        for (int j = 0; j < 4; ++j) { v[j] = xr[64 * j]; s += (v[j].x * v[j].x + v[j].y * v[j].y) + (v[j].z * v[j].z + v[j].w * v[j].w); }
        s = wave_sum(s);
        v2u* o8 = (v2u*)(HBA + (size_t)m * D) + F.lane;
#pragma unroll
        for (int j = 0; j < 4; ++j) { v2u w; w.x = pk2(v[j].x, v[j].y); w.y = pk2(v[j].z, v[j].w); o8[64 * j] = w; }
        if (F.lane == 0) *(f32x4*)(SSQ + (size_t)m * 4) = (f32x4){s, 0.f, 0.f, 0.f};
      } }
}


#ifdef DBG
__device__ __forceinline__ float bf2f(bf16 v) { return __uint_as_float((unsigned)v << 16); }
__device__ __forceinline__ float sp2(float z) { return fmaxf(z, 0.f) + lg2(1.f + ex2(-fabsf(z))); }
__device__ __forceinline__ float row_rinv_direct(const float* row, int lane) { float s = 0.f; for (int k = lane; k < D; k += 64) s += row[k] * row[k]; s = wave_sum(s); return rsqrtf(s * (1.f / D) + 1e-6f); }
__device__ __forceinline__ float dotcol(const float* row, const float* g, const float* W, int K, int ldw, int c, int lane) { float s = 0.f; for (int k = lane; k < K; k += 64) s += row[k] * (g ? g[k] : 1.f) * W[(size_t)k * ldw + c]; return wave_sum(s); }
__device__ __forceinline__ float dotcol_bf(const bf16* row, const float* W, int K, int ldw, int c, int lane) { float s = 0.f; for (int k = lane; k < K; k += 64) s += bf2f(row[k]) * W[(size_t)k * ldw + c]; return wave_sum(s); }
__device__ __forceinline__ void dbg_rec(float* dbg, int slot, float err) { if (err > dbg[slot] || !(err == err)) dbg[slot] = (err == err) ? err : 1e9f; }
#define TS(s) ((s) == 0 ? 5 : (s) == 1 ? 300 : (s) == 2 ? 4097 : 16383)
#define CS4(s) ((s) == 0 ? 3 : (s) == 1 ? 300 : (s) == 2 ? 777 : 1023)
__device__ __forceinline__ void dbg_check(int stage, const Frame& F) {
    if (blockIdx.x != 0 || F.wave != 0) return;
    ArgsP A = argp(); const int lane = F.lane;
    float* dbg = WSP(float, 32768);
    const float* x = A->in[IN_X]; float* out = A->out;
    const bf16* QB = WSP(bf16, WS_Q); const bf16* KB = WSP(bf16, WS_K); const bf16* VB = WSP(bf16, WS_V); const bf16* ACT = WSP(bf16, WS_ACT);
    if (stage == 1) {
        for (int s = 0; s < 6; ++s) { const int t = TS(s & 3), c = (s == 0 ? 5 : s == 1 ? 700 : s == 2 ? 1029 : s == 3 ? 2000 : s == 4 ? 2100 : 3000); const float* row = x + (size_t)t * D;
            const float ri = row_rinv_direct(row, lane); float ref = dotcol(row, A->in[IN_ATTN_G], A->in[IN_SB_WQKV], D, 3 * D, c, lane) * ri; if (c < 1024) ref *= QSCALE;
            const float got = bf2f(QB[(size_t)(c >> 10) * M * D + (size_t)t * D + (c & 1023)]);
            if (lane == 0) dbg_rec(dbg, 1, fabsf(ref - got) / (fabsf(ref) + 0.3f)); }
    } else if (stage == 2) {
        for (int s = 0; s < 4; ++s) { const int t = TS(s), h = (s == 0 ? 0 : s == 1 ? 3 : s == 2 ? 7 : 15); const float* row = x + (size_t)t * D; const float ri = row_rinv_direct(row, lane);
            float q = 0.f; for (int k = 0; k < D; ++k) q += row[k] * A->in[IN_ATTN_G][k] * A->in[IN_SB_WQKV][(size_t)k * 3 * D + h * 64 + lane]; q *= ri * QSCALE;
            float later = 0.f, o = 0.f;
            for (int kk = t - 1; kk >= 0 && kk >= t - 600; --kk) { const float z = wave_sum(q * bf2f(KB[(size_t)kk * D + h * 64 + lane])); const float sp = sp2(z);
                const float w = ex2(z - sp + later); later -= sp; o += w * bf2f(VB[(size_t)kk * D + h * 64 + lane]); }
            const float got = bf2f(QB[(size_t)t * D + h * 64 + lane]); const float e = wave_max(fabsf(o - got));
            if (lane == 0) dbg_rec(dbg, 2, e); }
    } else if (stage == 3) {
        for (int s = 0; s < 4; ++s) { const int t = TS(s), c = CS4(s);
            const float ref = x[(size_t)t * D + c] + dotcol_bf(QB + (size_t)t * D, A->in[IN_SB_WO], D, D, c, lane); const float got = out[(size_t)t * D + c];
            if (lane == 0) { dbg_rec(dbg, 3, fabsf(ref - got) / (fabsf(ref) + 0.3f)); dbg[64 + s] = got; }
            float ss = 0.f; for (int k = lane; k < D; k += 64) ss += out[(size_t)t * D + k] * out[(size_t)t * D + k]; ss = wave_sum(ss);
            const float* sq = WSP(float, WS_SSQ + (size_t)1 * M * 16) + (size_t)t * 4; const float got2 = sq[0] + sq[1] + sq[2] + sq[3];
            if (lane == 0) dbg_rec(dbg, 4, fabsf(ss - got2) / (ss + 1.f)); }
    } else if (stage == 4) {
        for (int s = 0; s < 4; ++s) { const int t = TS(s), j = (s == 0 ? 1 : s == 1 ? 130 : s == 2 ? 1500 : 2815); const float* row = out + (size_t)t * D; const float ri = row_rinv_direct(row, lane);
            const float g = dotcol(row, A->in[IN_FFN_G], A->in[IN_WGU], D, 2 * FF, j, lane) * ri, u = dotcol(row, A->in[IN_FFN_G], A->in[IN_WGU], D, 2 * FF, FF + j, lane) * ri;
            const float ref = g / (1.f + expf(-g)) * u, got = bf2f(ACT[(size_t)t * FF + j]);
            if (lane == 0) dbg_rec(dbg, 5, fabsf(ref - got) / (fabsf(ref) + 0.3f)); }
    } else if (stage == 5) {
        for (int s = 0; s < 4; ++s) { const int t = TS(s), c = CS4(s);
            const float ref = dbg[64 + s] + dotcol_bf(ACT + (size_t)t * FF, A->in[IN_WD], FF, D, c, lane), got = out[(size_t)t * D + c];
            if (lane == 0) dbg_rec(dbg, 6, fabsf(ref - got) / (fabsf(ref) + 0.3f)); }
        for (int s = 0; s < 4; ++s) for (int k = lane; k < D; k += 64) dbg[128 + s * D + k] = out[(size_t)TS(s) * D + k];
    } else if (stage == 6) {
        for (int s = 0; s < 4; ++s) { const int t = TS(s), c = CS4(s); const float* row = dbg + 128 + s * D; const float ri = row_rinv_direct(row, lane);
            const float a = dotcol(row, A->in[IN_PLE_G], A->in[IN_WGATE], D, D, c, lane) * ri; const float pr = dotcol(A->in[IN_P] + (size_t)t * PLE, nullptr, A->in[IN_WPROJ], PLE, D, c, lane);
            const float ref = row[c] + pr / (1.f + expf(-a)), got = out[(size_t)t * D + c];
            if (lane == 0) { dbg_rec(dbg, 7, fabsf(ref - got) / (fabsf(ref) + 0.3f)); const float pb = bf2f(WSP(bf16, WS_PROJ)[(size_t)t * D + c]); dbg_rec(dbg, 5, fabsf(pr - pb) / (fabsf(pr) + 0.3f)); } }
    }
    __builtin_amdgcn_s_waitcnt(0);
}
__device__ __forceinline__ void dbg_finish(const Frame& F) {
    if (blockIdx.x != 0 || F.tid != 0) return;
    ArgsP A = argp(); const float* dbg = WSP(float, 32768);
    int code = 0; for (int s = 7; s >= 1; --s) if (dbg[s] > 0.06f) code = s;
    A->out[0] = 10000.f * (float)code + 1000.f * fminf(dbg[code ? code : 1] * 10.f, 9.f) + 100.f;
}
#define DBG_CHECK(s) do { dbg_check((s), F); xcd_barrier(bar); } while (0)
#else
#define DBG_CHECK(s) do {} while (0)
#endif
template <int L> __device__ __forceinline__ void layer(const Frame& F, const XcdBarrier& bar) {
    constexpr size_t SSQ_A = WS_SSQ + (size_t)(3 * L) * M * 16, SSQ_B = WS_SSQ + (size_t)(3 * L + 1) * M * 16, SSQ_C = WS_SSQ + (size_t)(3 * L + 2) * M * 16, SSQ_D = WS_SSQ + (size_t)(3 * L + 3) * M * 16;
    if (L == 0) {
        ArgsP A = argp();
        pg8::Gemm g{WSP(bf16, WS_HBA), WSP(bf16, WS_WQKV0), M, 3 * D, D}; pg8::StaticOrder S; S.init(M, 3 * D, F.G, (int)blockIdx.x);
        pg8::EpiQKV0 E{WSP(bf16, WS_Q), (size_t)M * D, WSP(float, SSQ_A), QSCALE};
        pg8::gemm_phase<pg8::EpiQKV0, pg8::StaticOrder, true, true>(F.lds, g, S, E);
    } else {
        { ArgsP A = argp(); const bf16* HBB = WSP(bf16, WS_HBB); const bf16* WF = WSP(bf16, WS_WF); float* LS2 = WSP(float, WS_LS2); const float* ssq = WSP(float, SSQ_A); const float* b_f = A->in[IN_BF];
          for (int rb = blockIdx.x; rb < M / 64; rb += F.G) {
            if (F.wave < 4) { const int fr = F.lane & 15, fq = F.lane >> 4, row0 = rb * 64 + F.wave * 16;
                const bf16* ap = HBB + (size_t)(row0 + fr) * D + 8 * fq; const bf16* bp = WF + (size_t)fr * D + 8 * fq;
                f32x4 acc = {0.f, 0.f, 0.f, 0.f};
#pragma unroll 8
                for (int kk = 0; kk < 32; ++kk) { const bf16x8 a = *(const bf16x8*)(ap + kk * 32), b = *(const bf16x8*)(bp + kk * 32); acc = __builtin_amdgcn_mfma_f32_16x16x32_bf16(a, b, acc, 0, 0, 0); }
                const float bias = b_f[fr]; f32x4 o;
#pragma unroll
                for (int i = 0; i < 4; ++i) { const float f2 = (acc[i] * pg8::row_rinv(ssq, row0 + 4 * fq + i) + bias) * LOG2E_F;
                    o[i] = -(fmaxf(-f2, 0.f) + lg2(1.f + ex2(-fabsf(f2)))); }
                *(f32x4*)(LS2 + (size_t)fr * M + row0 + 4 * fq) = o; }
          } }
        ArgsP A = argp();
        pg8::Gemm g{WSP(bf16, WS_HBB), WSP(bf16, WS_WKVQ1), M, 3 * D, D}; pg8::StaticOrder S; S.init(M, 3 * D, F.G, (int)blockIdx.x);
        pg8::EpiKVQ1 E{WSP(bf16, WS_Q), (size_t)M * D, WSP(float, SSQ_A), A->in[IN_KNORM_G], A->in[IN_QNORM_G], QSCALE};
        pg8::gemm_phase<pg8::EpiKVQ1, pg8::StaticOrder, true, true>(F.lds, g, S, E);
    }
    xcd_barrier(bar);
    if (L == 0) DBG_CHECK(1);
    {
        ArgsP A = argp();
        float bound2 = 0.f;
        if (L == 1) { const float mq = wave_max(fabsf(A->in[IN_QNORM_G][F.lane])), mk = wave_max(fabsf(A->in[IN_KNORM_G][F.lane])); bound2 = 2.0f * 1.02f * 8.0f * LOG2E_F * mq * mk; }
        bf16* QB = WSP(bf16, WS_Q); const bf16* KB = WSP(bf16, WS_K); const bf16* VB = WSP(bf16, WS_V); const float* LS2 = WSP(float, WS_LS2);
        for (int un = F.vcu; un < NH * (M / 256); un += F.G) { const int h = un >> 6, qb = un & 63;
            if (L == 0) att::sb_unit(h, qb, QB, KB, VB, QB, F.lds);
            else att::fox_unit(h, qb, QB, KB, VB, QB, LS2, bound2, F.lds); }
        __syncthreads();
    }
    xcd_barrier(bar);
    if (L == 0) DBG_CHECK(2);
    { ArgsP A = argp(); convert_p(F, A->in[IN_P] + (size_t)L * M * PLE, WSP(bf16, WS_PBUF)); }
    for (int idx = blockIdx.x; idx < 256; idx += F.G) {
        ArgsP A = argp();
        pg8::StaticOrder S0; S0.init(M, D, 256, idx); pg8::OneUnit S; S0.next(0, S.u);
        pg8::Gemm g{WSP(bf16, WS_Q), WSP(bf16, L == 0 ? WS_WO0 : WS_WO1), M, D, D};
        pg8::EpiRes E{L == 0 ? A->in[IN_X] : (const float*)A->out, A->out, WSP(bf16, WS_HBA), WSP(float, SSQ_B)};
        pg8::gemm_phase<pg8::EpiRes, pg8::OneUnit, false, true>(F.lds, g, S, E);
    }
    xcd_barrier(bar);
    if (L == 0) DBG_CHECK(3);
    {
        ArgsP A = argp();
        pg8::Gemm g{WSP(bf16, WS_HBA), WSP(bf16, WS_WGU) + (size_t)L * 2 * FF * D, M, 2 * FF, D}; pg8::StaticOrder S; S.init(M, 2 * FF, F.G, (int)blockIdx.x);
        pg8::EpiGU E{WSP(bf16, WS_ACT), WSP(float, SSQ_B)};
        pg8::gemm_phase<pg8::EpiGU, pg8::StaticOrder, true, true>(F.lds, g, S, E);
    }
    { const int rem = ((M / 256) * (2 * FF / 256)) % F.G, nlight = F.G - rem, lb = (int)blockIdx.x - rem;
      if (lb >= 0) for (int pu = lb; pu < 256; pu += nlight) {
        ArgsP A = argp(); pg8::StaticOrder S0; S0.init(M, D, 256, pu); pg8::OneUnit S; S0.next(0, S.u);
        pg8::Gemm g{WSP(bf16, WS_PBUF), WSP(bf16, WS_WP) + (size_t)L * D * PLE, M, D, PLE}; pg8::EpiProj E{WSP(bf16, WS_PROJ)};
        pg8::gemm_phase<pg8::EpiProj, pg8::OneUnit, false, true>(F.lds, g, S, E); } }
    xcd_barrier(bar);
    if (L == 0) DBG_CHECK(4);
    for (int idx = blockIdx.x; idx < 256; idx += F.G) {
        ArgsP A = argp();
        pg8::StaticOrder S0; S0.init(M, D, 256, idx); pg8::OneUnit S; S0.next(0, S.u);
        pg8::Gemm g{WSP(bf16, WS_ACT), WSP(bf16, WS_WD) + (size_t)L * D * FF, M, D, FF};
        pg8::EpiRes E{A->out, A->out, WSP(bf16, WS_HBA), WSP(float, SSQ_C)};
        pg8::gemm_phase<pg8::EpiRes, pg8::OneUnit, false, true>(F.lds, g, S, E);
    }
    xcd_barrier(bar);
    if (L == 0) DBG_CHECK(5);
    for (int idx = blockIdx.x; idx < 256; idx += F.G) {
        pg8::StaticOrder S0; S0.init(M, D, 256, idx); pg8::OneUnit S; S0.next(0, S.u);
        { ArgsP A = argp(); pg8::Gemm g{WSP(bf16, WS_HBA), WSP(bf16, WS_WG) + (size_t)L * D * D, M, D, D};
          pg8::EpiPle E{WSP(float, SSQ_C), WSP(bf16, WS_PROJ), A->out, L == 0 ? WSP(bf16, WS_HBB) : (bf16*)nullptr, L == 0 ? WSP(float, SSQ_D) : (float*)nullptr};
          pg8::gemm_phase<pg8::EpiPle, pg8::OneUnit, false, true>(F.lds, g, S, E); }
    }
    if (L == 0) { xcd_barrier(bar); DBG_CHECK(6); }
#ifdef DBG
    if (L == 1) { xcd_barrier(bar); dbg_finish(F); }
#endif
}

__global__ void __launch_bounds__(NWAVES * 64, 2) mega_fwd(Args args) {
    extern __shared__ __attribute__((aligned(16))) unsigned char lds_raw[];
    Frame F;
    F.lds = (LAS unsigned char*)lds_raw;
    F.tid = threadIdx.x; F.lane = F.tid & 63; F.wave = __builtin_amdgcn_readfirstlane(F.tid >> 6);
    F.G = gridDim.x; { const int bx = blockIdx.x; F.vcu = (F.G % 8 == 0) ? (bx % 8) * (F.G / 8) + bx / 8 : bx; }
    volatile LAS unsigned* MISC = (volatile LAS unsigned*)(F.lds + MISC_OFF);
    for (int u = F.tid; u < (LDS_BYTES - RING_BYTES) / 4; u += NWAVES * 64) ((LAS unsigned*)(F.lds + RING_BYTES))[u] = 0u;
    __syncthreads();
    XcdBarrier bar;
    { ArgsP A = argp(); bar = xcd_barrier_post(WSP(unsigned, WS_CTL) + CW_BAR, MISC + 8); }
    prologue(F);
    if (gridDim.y == 0x7fffu) cg::this_grid().sync();
    xcd_barrier(bar);
    layer<0>(F, bar);
    layer<1>(F, bar);
    (void)args;
}

extern "C" void kernel_launch(void* const* d_in, const int* in_sizes, int n_in, void* d_out, int out_size, void* d_ws, size_t ws_size, hipStream_t stream) {
    static int grid = 0;
    if (grid == 0) {
        if (n_in != 18 || in_sizes[0] != M * D || out_size != M * D || ws_size < WS_END) { fprintf(stderr, "kernel_launch: unexpected shapes (n_in %d, in0 %d, out %d, ws %zu); nothing launched\n", n_in, n_in > 0 ? in_sizes[0] : -1, out_size, ws_size); grid = -1; return; }
        int dev = 0, cus = 0, per_cu = 0;
        if (hipGetDevice(&dev) != hipSuccess || hipDeviceGetAttribute(&cus, hipDeviceAttributeMultiprocessorCount, dev) != hipSuccess) { fprintf(stderr, "kernel_launch: device query failed\n"); grid = -1; return; }
        if (hipFuncSetAttribute((const void*)mega_fwd, hipFuncAttributeMaxDynamicSharedMemorySize, LDS_BYTES) != hipSuccess) { fprintf(stderr, "kernel_launch: hipFuncSetAttribute failed\n"); grid = -1; return; }
        if (hipOccupancyMaxActiveBlocksPerMultiprocessor(&per_cu, (const void*)mega_fwd, NWAVES * 64, LDS_BYTES) != hipSuccess || per_cu < 1) { fprintf(stderr, "kernel_launch: occupancy query says %d\n", per_cu); per_cu = 1; }
        (void)hipGetLastError();
        grid = cus * per_cu;
    }
    if (grid < 0) return;
    if (hipMemsetAsync((char*)d_ws + WS_CTL, 0, CTL_ZERO_BYTES, stream) != hipSuccess) { fprintf(stderr, "kernel_launch: memset failed\n"); return; }
    Args a{};
    for (int i = 0; i < 18; ++i) a.in[i] = (const float*)d_in[i];
    a.out = (float*)d_out; a.ws = (unsigned char*)d_ws;
    void* kargs[] = {&a};
    const hipError_t e = hipLaunchCooperativeKernel((const void*)mega_fwd, dim3(grid), dim3(NWAVES * 64), kargs, LDS_BYTES, stream);
    if (e != hipSuccess) fprintf(stderr, "kernel_launch: cooperative launch failed: %s (grid %d)\n", hipGetErrorString(e), grid);
}
```

```cpp
#include <hip/hip_runtime.h>
#include <hip/hip_cooperative_groups.h>
#include <cstdio>
#include <cstdint>
namespace cg = cooperative_groups;
namespace pg8 {
#define PG8_LAS __attribute__((address_space(3)))
typedef unsigned short bf16_t;
typedef short bf16x8 __attribute__((ext_vector_type(8)));
typedef float f32x4 __attribute__((ext_vector_type(4)));
typedef unsigned u32x4 __attribute__((ext_vector_type(4)));
constexpr int BM = 256, BK = 64, HALF = 128, HTB = HALF * BK * 2  , STAGE_BYTES = 8 * HTB, NXCD = 8, WGM = 8;

__host__ __device__ __forceinline__ int lds_byte(int r, int c) { const int st = (r >> 4) * 2 + (c >> 5), rr = r & 15, cc = c & 31, ob = rr * 64 + cc * 2; return st * 1024 + (ob ^ (((ob >> 9) & 1) << 5)); }
__host__ __device__ __forceinline__ void stage_rc(int b, int& R, int& C) { const int st = b / 1024, sb = b % 1024, swz = sb ^ (((sb >> 9) & 1) << 5); R = (st >> 1) * 16 + swz / 64; C = (st & 1) * 32 + (swz % 64) / 2; }
__host__ __device__ __forceinline__ int perm32(int rho) { const int n = rho >> 4, i = rho & 15; return 8 * (i >> 2) + 4 * n + (i & 3); }

struct Unit { int pm, pn; };
struct Gemm { const bf16_t* A; const bf16_t* Bt; int M, N, K; };

struct StaticOrder {
    int nM, nN, nwg, G, c;
    __host__ __device__ void init(int M, int N, int G_, int c_) { nM = M / BM; nN = N / BM; nwg = nM * nN; G = G_; c = c_; }
    __host__ __device__ bool next(int i, Unit& u) const {
        const long L = (long)i * G + c; if (L >= nwg) return false;
        int wgid = (int)L; { const int q = nwg / NXCD, r = nwg % NXCD, xcd = wgid % NXCD, off = wgid / NXCD; wgid = (xcd < r ? xcd * (q + 1) : r * (q + 1) + (xcd - r) * q) + off; }
        const int nig = WGM * nN, gid = wgid / nig, fm = gid * WGM, gsz = (nM - fm) < WGM ? (nM - fm) : WGM;
        u.pm = fm + ((wgid % nig) % gsz); u.pn = (wgid % nig) / gsz; return true;
    }
    __device__ __forceinline__ void a_ready(const Unit&) const {}
    __device__ __forceinline__ void done(const Unit&) const {}
};


typedef unsigned u32x2 __attribute__((ext_vector_type(2)));
__device__ __forceinline__ unsigned cvt_pk_bf16(float lo, float hi) { unsigned r; asm volatile("v_cvt_pk_bf16_f32 %0, %1, %2" : "=v"(r) : "v"(lo), "v"(hi)); return r; }
constexpr float RMS_EPS = 1e-6f, LOG2E = 1.4426950408889634f;
__device__ __forceinline__ float row_rinv(const float* ssq, int row) { const f32x4 s = *(const f32x4*)(ssq + (size_t)row * 4); return rsqrtf(((s[0] + s[1]) + (s[2] + s[3])) * (1.0f / 1024.0f) + RMS_EPS); }
__device__ __forceinline__ float sigmoid_f(float a) { return __builtin_amdgcn_rcpf(1.0f + __builtin_amdgcn_exp2f(-a * LOG2E)); }

struct EpiQKV0 {
    static constexpr bool PERM = true, AFTER_DRAIN = false;
    bf16_t* O; size_t tstride; const float* ssq; float qscale;
    __device__ __forceinline__ void operator()(const f32x4 (&acc)[2][2][4][2], const Unit& u, int wr, int wc, int fr, int fq) const {
        const int row0 = u.pm * BM + wr * 64 + fr; const int t = u.pn >> 2; bf16_t* base = O + (size_t)t * tstride;
        const float sc = (t == 0) ? qscale : 1.f; const int col0 = (u.pn & 3) * 256 + wc * 32 + 8 * fq;
        float ri[2][4];
#pragma unroll
        for (int ai = 0; ai < 2; ++ai)
#pragma unroll
            for (int m = 0; m < 4; ++m) ri[ai][m] = row_rinv(ssq, row0 + ai * HALF + m * 16) * sc;
#pragma unroll
        for (int ai = 0; ai < 2; ++ai)
#pragma unroll
            for (int m = 0; m < 4; ++m) { const int row = row0 + ai * HALF + m * 16; const float r = ri[ai][m]; bf16_t* rowp = base + (size_t)row * 1024 + col0;
#pragma unroll
                for (int bj = 0; bj < 2; ++bj) { const f32x4 v0 = acc[ai][bj][m][0] * r, v1 = acc[ai][bj][m][1] * r;
                    u32x4 w; w.x = cvt_pk_bf16(v0[0], v0[1]); w.y = cvt_pk_bf16(v0[2], v0[3]); w.z = cvt_pk_bf16(v1[0], v1[1]); w.w = cvt_pk_bf16(v1[2], v1[3]);
                    *(u32x4*)(rowp + bj * HALF) = w; } }
    }
};
struct EpiKVQ1 {
    static constexpr bool PERM = true, AFTER_DRAIN = false;
    bf16_t* O; size_t tstride; const float* ssq; const float* gk; const float* gq; float qscale;
    __device__ __forceinline__ void operator()(const f32x4 (&acc)[2][2][4][2], const Unit& u, int wr, int wc, int fr, int fq) const {
        const int row0 = u.pm * BM + wr * 64 + fr; const int t = u.pn >> 2; bf16_t* base = O + (size_t)((t + 1) % 3) * tstride;
        const int head = (u.pn & 3) * 4 + wc;
        f32x4 gv[2][2];
        if (t != 1) { const float* g = (t == 0) ? gk : gq; const float s = (t == 0) ? 1.f : qscale;
#pragma unroll
            for (int bj = 0; bj < 2; ++bj)
#pragma unroll
                for (int n = 0; n < 2; ++n) gv[bj][n] = *(const f32x4*)(g + 32 * bj + 8 * fq + 4 * n) * s; }
        float ri[2][4];
#pragma unroll
        for (int ai = 0; ai < 2; ++ai)
#pragma unroll
            for (int m = 0; m < 4; ++m) ri[ai][m] = row_rinv(ssq, row0 + ai * HALF + m * 16);
#pragma unroll
        for (int ai = 0; ai < 2; ++ai)
#pragma unroll
            for (int m = 0; m < 4; ++m) { const int row = row0 + ai * HALF + m * 16; const float r = ri[ai][m];
                f32x4 v[2][2];
#pragma unroll
                for (int bj = 0; bj < 2; ++bj)
#pragma unroll
                    for (int n = 0; n < 2; ++n) v[bj][n] = acc[ai][bj][m][n] * r;
                if (t != 1) { float ss = 0.f;
#pragma unroll
                    for (int bj = 0; bj < 2; ++bj)
#pragma unroll
                        for (int n = 0; n < 2; ++n) { const f32x4 x = v[bj][n]; ss += (x[0] * x[0] + x[1] * x[1]) + (x[2] * x[2] + x[3] * x[3]); }
                    ss += __shfl_xor(ss, 16); ss += __shfl_xor(ss, 32);
                    const float rn = rsqrtf(ss * (1.0f / 64.0f) + RMS_EPS);
#pragma unroll
                    for (int bj = 0; bj < 2; ++bj)
#pragma unroll
                        for (int n = 0; n < 2; ++n) v[bj][n] = v[bj][n] * rn * gv[bj][n]; }
                bf16_t* rowp = base + (size_t)row * 1024 + head * 64 + 8 * fq;
#pragma unroll
                for (int bj = 0; bj < 2; ++bj) { const f32x4 v0 = v[bj][0], v1 = v[bj][1];
                    u32x4 w; w.x = cvt_pk_bf16(v0[0], v0[1]); w.y = cvt_pk_bf16(v0[2], v0[3]); w.z = cvt_pk_bf16(v1[0], v1[1]); w.w = cvt_pk_bf16(v1[2], v1[3]);
                    *(u32x4*)(rowp + 32 * bj) = w; } }
    }
};
struct EpiGU {
    static constexpr bool PERM = true, AFTER_DRAIN = false;
    bf16_t* O; const float* ssq;
    __device__ __forceinline__ void operator()(const f32x4 (&acc)[2][2][4][2], const Unit& u, int wr, int wc, int fr, int fq) const {
        const int row0 = u.pm * BM + wr * 64 + fr; const int col0 = u.pn * 128 + wc * 32 + 8 * fq;
        float ri[2][4];
#pragma unroll
        for (int ai = 0; ai < 2; ++ai)
#pragma unroll
            for (int m = 0; m < 4; ++m) ri[ai][m] = row_rinv(ssq, row0 + ai * HALF + m * 16);
#pragma unroll
        for (int ai = 0; ai < 2; ++ai)
#pragma unroll
            for (int m = 0; m < 4; ++m) { const int row = row0 + ai * HALF + m * 16; const float r = ri[ai][m]; bf16_t* rowp = O + (size_t)row * 2816 + col0;
                f32x4 a[2]; const float c1 = -r * LOG2E, r2 = r * r;
#pragma unroll
                for (int n = 0; n < 2; ++n) { const f32x4 ag = acc[ai][0][m][n], au = acc[ai][1][m][n]; f32x4 ea = ag * c1; const f32x4 pr = (ag * au) * r2;
#pragma unroll
                    for (int i = 0; i < 4; ++i) ea[i] = __builtin_amdgcn_rcpf(1.0f + __builtin_amdgcn_exp2f(ea[i]));
                    a[n] = pr * ea; }
                u32x4 w; w.x = cvt_pk_bf16(a[0][0], a[0][1]); w.y = cvt_pk_bf16(a[0][2], a[0][3]); w.z = cvt_pk_bf16(a[1][0], a[1][1]); w.w = cvt_pk_bf16(a[1][2], a[1][3]);
                *(u32x4*)rowp = w; }
    }
};
__device__ __forceinline__ void bf8_to_f32(u32x4 pw, f32x4& lo, f32x4& hi_) {
    lo[0] = __uint_as_float(pw.x << 16); lo[1] = __uint_as_float(pw.x & 0xffff0000u); lo[2] = __uint_as_float(pw.y << 16); lo[3] = __uint_as_float(pw.y & 0xffff0000u);
    hi_[0] = __uint_as_float(pw.z << 16); hi_[1] = __uint_as_float(pw.z & 0xffff0000u); hi_[2] = __uint_as_float(pw.w << 16); hi_[3] = __uint_as_float(pw.w & 0xffff0000u); }
__device__ __forceinline__ u32x4 f32_to_bf8(const f32x4& v0, const f32x4& v1) { u32x4 w; w.x = cvt_pk_bf16(v0[0], v0[1]); w.y = cvt_pk_bf16(v0[2], v0[3]); w.z = cvt_pk_bf16(v1[0], v1[1]); w.w = cvt_pk_bf16(v1[2], v1[3]); return w; }
__device__ __forceinline__ float sumsq4(const f32x4& v) { return (v[0] * v[0] + v[1] * v[1]) + (v[2] * v[2] + v[3] * v[3]); }
struct EpiProj {
    static constexpr bool PERM = true, AFTER_DRAIN = false;
    bf16_t* O;
    __device__ __forceinline__ void operator()(const f32x4 (&acc)[2][2][4][2], const Unit& u, int wr, int wc, int fr, int fq) const {
        const int row0 = u.pm * BM + wr * 64 + fr; const int col0 = u.pn * BM + wc * 32 + 8 * fq;
#pragma unroll
        for (int ai = 0; ai < 2; ++ai)
#pragma unroll
            for (int m = 0; m < 4; ++m) { bf16_t* rowp = O + (size_t)(row0 + ai * HALF + m * 16) * 1024 + col0;
#pragma unroll
                for (int bj = 0; bj < 2; ++bj) *(u32x4*)(rowp + bj * HALF) = f32_to_bf8(acc[ai][bj][m][0], acc[ai][bj][m][1]); }
    }
};
template <bool BASE_F32> struct EpiRes {
    static constexpr bool PERM = true, AFTER_DRAIN = true;
    const void* base; bf16_t* hb; float* ssq_out;
    __device__ __forceinline__ void fused(const f32x4 (&acc)[2][2][4][2], const Unit& u, int wr, int wc, int fr, int fq, PG8_LAS unsigned char* lds, int wid, int lane) const {
        PG8_LAS float* P = (PG8_LAS float*)lds;
        const int col0 = u.pn * BM + wc * 32 + 8 * fq;
#pragma unroll
        for (int ai = 0; ai < 2; ++ai) {
            f32x4 b0[4][2], b1[4][2];
#pragma unroll
            for (int m = 0; m < 4; ++m) { const size_t off = (size_t)(u.pm * BM + ai * HALF + wr * 64 + m * 16 + fr) * 1024 + col0;
#pragma unroll
                for (int bj = 0; bj < 2; ++bj) { const size_t o2 = off + bj * HALF;
                    if (BASE_F32) { b0[m][bj] = *(const f32x4*)((const float*)base + o2); b1[m][bj] = *(const f32x4*)((const float*)base + o2 + 4); }
                    else bf8_to_f32(*(const u32x4*)((const bf16_t*)base + o2), b0[m][bj], b1[m][bj]); } }
#pragma unroll
            for (int m = 0; m < 4; ++m) { const int r = ai * HALF + wr * 64 + m * 16 + fr; const size_t off = (size_t)(u.pm * BM + r) * 1024 + col0; float s = 0.f;
#pragma unroll
                for (int bj = 0; bj < 2; ++bj) { const f32x4 v0 = b0[m][bj] + acc[ai][bj][m][0], v1 = b1[m][bj] + acc[ai][bj][m][1];
                    *(u32x4*)(hb + off + bj * HALF) = f32_to_bf8(v0, v1); s += sumsq4(v0) + sumsq4(v1); }
                s += __shfl_xor(s, 16); s += __shfl_xor(s, 32);
                if (fq == 0) P[r * 4 + wc] = s; } }
        asm volatile("s_waitcnt lgkmcnt(0)" ::: "memory"); __builtin_amdgcn_s_barrier(); asm volatile("" ::: "memory");
        const int tid = wid * 64 + lane;
        if (tid < 256) { const f32x4 p = *(const PG8_LAS f32x4*)(P + tid * 4); ssq_out[(size_t)(u.pm * BM + tid) * 4 + u.pn] = (p[0] + p[1]) + (p[2] + p[3]); }
        asm volatile("s_waitcnt lgkmcnt(0)" ::: "memory"); __builtin_amdgcn_s_barrier(); asm volatile("" ::: "memory");
    }
};
struct EpiPle {
    static constexpr bool PERM = true, AFTER_DRAIN = true;
    const float* ssq_in; const bf16_t* hin; const bf16_t* projp; bf16_t* hb_out; float* fout; float* ssq_out;
    __device__ __forceinline__ void fused(const f32x4 (&acc)[2][2][4][2], const Unit& u, int wr, int wc, int fr, int fq, PG8_LAS unsigned char* lds, int wid, int lane) const {
        PG8_LAS float* P = (PG8_LAS float*)lds;
        const int col0 = u.pn * BM + wc * 32 + 8 * fq;
        float riv[2][4];
#pragma unroll
        for (int ai = 0; ai < 2; ++ai)
#pragma unroll
            for (int m = 0; m < 4; ++m) riv[ai][m] = row_rinv(ssq_in, u.pm * BM + ai * HALF + wr * 64 + m * 16 + fr);
#pragma unroll
        for (int ai = 0; ai < 2; ++ai) {
            u32x4 hv[4][2], pv[4][2];
#pragma unroll
            for (int m = 0; m < 4; ++m) { const size_t off = (size_t)(u.pm * BM + ai * HALF + wr * 64 + m * 16 + fr) * 1024 + col0;
#pragma unroll
                for (int bj = 0; bj < 2; ++bj) { hv[m][bj] = *(const u32x4*)(hin + off + bj * HALF); pv[m][bj] = *(const u32x4*)(projp + off + bj * HALF); } }
#pragma unroll
            for (int m = 0; m < 4; ++m) { const int r = ai * HALF + wr * 64 + m * 16 + fr; const size_t off = (size_t)(u.pm * BM + r) * 1024 + col0; float s = 0.f;
                const float ri = riv[ai][m];
#pragma unroll
                for (int bj = 0; bj < 2; ++bj) { const size_t o2 = off + bj * HALF; f32x4 h0, h1, p0, p1; bf8_to_f32(hv[m][bj], h0, h1); bf8_to_f32(pv[m][bj], p0, p1);
                    const f32x4 a0 = acc[ai][bj][m][0] * ri, a1 = acc[ai][bj][m][1] * ri; f32x4 v0, v1;
#pragma unroll
                    for (int i = 0; i < 4; ++i) { v0[i] = h0[i] + sigmoid_f(a0[i]) * p0[i]; v1[i] = h1[i] + sigmoid_f(a1[i]) * p1[i]; }
                    if (fout) { *(f32x4*)(fout + o2) = v0; *(f32x4*)(fout + o2 + 4) = v1; }
                    if (hb_out) *(u32x4*)(hb_out + o2) = f32_to_bf8(v0, v1);
                    s += sumsq4(v0) + sumsq4(v1); }
                s += __shfl_xor(s, 16); s += __shfl_xor(s, 32);
                if (fq == 0) P[r * 4 + wc] = s; } }
        asm volatile("s_waitcnt lgkmcnt(0)" ::: "memory"); __builtin_amdgcn_s_barrier(); asm volatile("" ::: "memory");
        const int tid = wid * 64 + lane;
        if (ssq_out && tid < 256) { const f32x4 p = *(const PG8_LAS f32x4*)(P + tid * 4); ssq_out[(size_t)(u.pm * BM + tid) * 4 + u.pn] = (p[0] + p[1]) + (p[2] + p[3]); }
        asm volatile("s_waitcnt lgkmcnt(0)" ::: "memory"); __builtin_amdgcn_s_barrier(); asm volatile("" ::: "memory");
    }
};
struct OneUnit {
    Unit u;
    __device__ __forceinline__ bool next(int i, Unit& o) const { if (i) return false; o = u; return true; }
    __device__ __forceinline__ void a_ready(const Unit&) const {}
    __device__ __forceinline__ void done(const Unit&) const {}
};

template <class Epi, class Sched, bool ALIGN_EPI = false, bool SP2 = false>
__device__ __forceinline__ void gemm_phase(PG8_LAS unsigned char* lds, const Gemm g, const Sched& S, const Epi& E) {
    int tid_ = threadIdx.x; asm volatile("" : "+v"(tid_));
    const int tid = tid_, wid = __builtin_amdgcn_readfirstlane(tid >> 6), lane = tid & 63, wr = wid >> 2, wc = wid & 3, fr = lane & 15, fq = lane >> 4;
    const int K = g.K, nt = K / BK;
    unsigned voffA[2], voffB[2];
#pragma unroll
    for (int i = 0; i < 2; ++i) { int R, C; stage_rc(tid * 16 + i * 8192, R, C); const int Rb = Epi::PERM ? ((R & ~31) + perm32(R & 31)) : R;
        voffA[i] = (unsigned)(R * K + C) * 2u; voffB[i] = (unsigned)(Rb * K + C) * 2u; }
    const size_t kstep = (size_t)(BK * 2);
    const size_t hstep = (size_t)HALF * K * 2;
    const size_t tstep = 2 * hstep;
    const unsigned ldsw = (unsigned)wid * 1024u;
    const int aoff = lds_byte(wr * 64 + fr, fq * 8), boff = lds_byte(wc * 32 + fr, fq * 8);
#define PG8_SA(b, h) (((b) * 2 + (h)) * HTB)
#define PG8_SB(b, h) ((4 + (b) * 2 + (h)) * HTB)
#define PG8_STAGE(bufoff, gbase, voff) do { _Pragma("unroll") for (int _i = 0; _i < 2; ++_i) \
        __builtin_amdgcn_global_load_lds((const unsigned*)((const char*)(gbase) + (voff)[_i]), (PG8_LAS unsigned*)(lds + (bufoff) + ldsw + _i * 8192), 16, 0, 0); } while (0)
#define PG8_LDA(dst, b, h) do { _Pragma("unroll") for (int m = 0; m < 4; ++m) _Pragma("unroll") for (int k = 0; k < 2; ++k) dst[m][k] = *(const PG8_LAS bf16x8*)(lds + PG8_SA(b, h) + aoff + m * 2048 + k * 1024); } while (0)
#define PG8_LDB(dst, b, h) do { _Pragma("unroll") for (int n = 0; n < 2; ++n) _Pragma("unroll") for (int k = 0; k < 2; ++k) dst[n][k] = *(const PG8_LAS bf16x8*)(lds + PG8_SB(b, h) + boff + n * 2048 + k * 1024); } while (0)
#define PG8_MMA(ai, bj, At, Bt) do { __builtin_amdgcn_s_setprio(1); _Pragma("unroll") for (int m = 0; m < 4; ++m) _Pragma("unroll") for (int n = 0; n < 2; ++n) _Pragma("unroll") for (int k = 0; k < 2; ++k) \
        acc[ai][bj][m][n] = __builtin_amdgcn_mfma_f32_16x16x32_bf16(Bt[n][k], At[m][k], acc[ai][bj][m][n], 0, 0, 0); __builtin_amdgcn_s_setprio(0); } while (0)
#define PG8_WAIT_V(n) asm volatile("s_waitcnt vmcnt(" #n ")" ::: "memory")
#define PG8_WAIT_L(n) asm volatile("s_waitcnt lgkmcnt(" #n ")" ::: "memory")
#define PG8_BAR __builtin_amdgcn_s_barrier()
#define PG8_SCHED __builtin_amdgcn_sched_barrier(0)
    Unit cur, nxt; int ui = 0;
    if (!S.next(0, cur)) return;
    f32x4 acc[2][2][4][2];
#pragma unroll
    for (int a = 0; a < 2; ++a)
#pragma unroll
        for (int b = 0; b < 2; ++b)
#pragma unroll
            for (int m = 0; m < 4; ++m)
#pragma unroll
                for (int n = 0; n < 2; ++n) acc[a][b][m][n] = (f32x4){0.f, 0.f, 0.f, 0.f};
    bf16x8 At[4][2], B0[2][2], B1[2][2];
    const char* cA = (const char*)g.A + (size_t)cur.pm * tstep; const char* cB = (const char*)g.Bt + (size_t)cur.pn * tstep;
    S.a_ready(cur);
    if constexpr (SP2) {
        PG8_STAGE(PG8_SB(0, 0), cB, voffB); PG8_STAGE(PG8_SB(0, 1), cB + hstep, voffB); PG8_STAGE(PG8_SA(0, 0), cA, voffA); PG8_STAGE(PG8_SA(0, 1), cA + hstep, voffA);
        if (wr == 1) PG8_BAR;
        PG8_WAIT_V(2); PG8_BAR;
        PG8_STAGE(PG8_SB(1, 0), cB + kstep, voffB); PG8_STAGE(PG8_SA(1, 0), cA + kstep, voffA); PG8_STAGE(PG8_SB(1, 1), cB + hstep + kstep, voffB);
        PG8_WAIT_V(6); PG8_BAR;
    } else {
        PG8_STAGE(PG8_SB(0, 0), cB, voffB); PG8_STAGE(PG8_SA(0, 0), cA, voffA); PG8_STAGE(PG8_SB(0, 1), cB + hstep, voffB); PG8_STAGE(PG8_SA(0, 1), cA + hstep, voffA);
        if (wr == 1) PG8_BAR;
        PG8_WAIT_V(4); PG8_BAR;
        PG8_STAGE(PG8_SB(1, 0), cB + kstep, voffB); PG8_STAGE(PG8_SA(1, 0), cA + kstep, voffA); PG8_STAGE(PG8_SB(1, 1), cB + hstep + kstep, voffB);
        PG8_WAIT_V(6); PG8_BAR;
    }
    for (;;) {
        const bool has_next = S.next(ui + 1, nxt);
        const char* nA = has_next ? (const char*)g.A + (size_t)nxt.pm * tstep : cA; const char* nB = has_next ? (const char*)g.Bt + (size_t)nxt.pn * tstep : cB;
        for (int t = 0; t < nt; t += 2) {
            const bool last = (t == nt - 2);
            const char* a1 = cA + (size_t)(t + 1) * kstep;
            const char* a2 = last ? nA : cA + (size_t)(t + 2) * kstep; const char* b2 = last ? nB : cB + (size_t)(t + 2) * kstep;
            const char* a3 = a2 + kstep; const char* b3 = b2 + kstep;
            if (last && has_next) S.a_ready(nxt);
            if constexpr (SP2) {
            PG8_LDB(B0, 0, 0); PG8_LDB(B1, 0, 1); PG8_SCHED; PG8_LDA(At, 0, 0); PG8_STAGE(PG8_SA(1, 1), a1 + hstep, voffA);
            PG8_WAIT_V(8); PG8_WAIT_L(0); PG8_BAR; PG8_MMA(0, 0, At, B0); PG8_MMA(0, 1, At, B1); PG8_BAR; PG8_SCHED;
            PG8_LDA(At, 0, 1); PG8_STAGE(PG8_SB(0, 0), b2, voffB); PG8_STAGE(PG8_SB(0, 1), b2 + hstep, voffB); PG8_STAGE(PG8_SA(0, 0), a2, voffA);
            PG8_WAIT_V(8); PG8_WAIT_L(0); PG8_BAR; PG8_MMA(1, 0, At, B0); PG8_MMA(1, 1, At, B1); PG8_BAR; PG8_SCHED;
            PG8_LDB(B0, 1, 0); PG8_LDB(B1, 1, 1); PG8_SCHED; PG8_LDA(At, 1, 0); PG8_STAGE(PG8_SA(0, 1), a2 + hstep, voffA);
            PG8_WAIT_V(8); PG8_WAIT_L(0); PG8_BAR; PG8_MMA(0, 0, At, B0); PG8_MMA(0, 1, At, B1); PG8_BAR; PG8_SCHED;
            PG8_LDA(At, 1, 1); PG8_STAGE(PG8_SB(1, 0), b3, voffB); PG8_STAGE(PG8_SB(1, 1), b3 + hstep, voffB); PG8_STAGE(PG8_SA(1, 0), a3, voffA);
            PG8_WAIT_V(8); PG8_WAIT_L(0); PG8_BAR; PG8_MMA(1, 0, At, B0); PG8_MMA(1, 1, At, B1); PG8_BAR; PG8_SCHED;
            } else {
            PG8_LDB(B0, 0, 0); PG8_SCHED; PG8_LDA(At, 0, 0); PG8_STAGE(PG8_SA(1, 1), a1 + hstep, voffA);
            PG8_WAIT_L(8); PG8_BAR; PG8_WAIT_L(0); PG8_MMA(0, 0, At, B0); PG8_BAR; PG8_SCHED;
            PG8_LDB(B1, 0, 1); PG8_STAGE(PG8_SB(0, 0), b2, voffB);
            PG8_BAR; PG8_WAIT_L(0); PG8_MMA(0, 1, At, B1); PG8_BAR;
            PG8_LDA(At, 0, 1); PG8_STAGE(PG8_SA(0, 0), a2, voffA);
            PG8_BAR; PG8_WAIT_L(0); PG8_MMA(1, 0, At, B0); PG8_BAR; PG8_SCHED;
            PG8_STAGE(PG8_SB(0, 1), b2 + hstep, voffB);
            PG8_WAIT_V(6); PG8_BAR; PG8_MMA(1, 1, At, B1); PG8_BAR;
            PG8_LDB(B0, 1, 0); PG8_SCHED; PG8_LDA(At, 1, 0); PG8_STAGE(PG8_SA(0, 1), a2 + hstep, voffA);
            PG8_WAIT_L(8); PG8_BAR; PG8_WAIT_L(0); PG8_MMA(0, 0, At, B0); PG8_BAR; PG8_SCHED;
            PG8_LDB(B1, 1, 1); PG8_STAGE(PG8_SB(1, 0), b3, voffB);
            PG8_BAR; PG8_WAIT_L(0); PG8_MMA(0, 1, At, B1); PG8_BAR;
            PG8_LDA(At, 1, 1); PG8_STAGE(PG8_SA(1, 0), a3, voffA);
            PG8_BAR; PG8_WAIT_L(0); PG8_MMA(1, 0, At, B0); PG8_BAR; PG8_SCHED;
            PG8_STAGE(PG8_SB(1, 1), b3 + hstep, voffB);
            PG8_WAIT_V(6); PG8_BAR; PG8_MMA(1, 1, At, B1); PG8_BAR;
            }
        }
        if constexpr (ALIGN_EPI) { if (wr == 0) PG8_BAR; }
        if constexpr (!Epi::AFTER_DRAIN) { E(acc, cur, wr, wc, fr, fq); S.done(cur); }
        if (!has_next) break;
#pragma unroll
        for (int a = 0; a < 2; ++a)
#pragma unroll
            for (int b = 0; b < 2; ++b)
#pragma unroll
                for (int m = 0; m < 4; ++m)
#pragma unroll
                    for (int n = 0; n < 2; ++n) acc[a][b][m][n] = (f32x4){0.f, 0.f, 0.f, 0.f};
        cur = nxt; cA = nA; cB = nB; ++ui;
        if constexpr (ALIGN_EPI) { if (wr == 1) PG8_BAR; }
    }
    PG8_WAIT_V(0);
    if constexpr (!ALIGN_EPI) { if (wr == 0) PG8_BAR; }
    PG8_BAR;
    if constexpr (Epi::AFTER_DRAIN) { E.fused(acc, cur, wr, wc, fr, fq, lds, wid, lane); S.done(cur); }
#undef PG8_SA
#undef PG8_SB
#undef PG8_STAGE
#undef PG8_LDA
#undef PG8_LDB
#undef PG8_MMA
#undef PG8_WAIT_V
#undef PG8_WAIT_L
#undef PG8_BAR
#undef PG8_SCHED
}
}

constexpr int M = 16384, D = 1024, NH = 16, DH = 64, FF = 2816, PLE = 256;
constexpr float LOG2E_F = 1.4426950408889634f;
constexpr float QSCALE = 0.125f * LOG2E_F;
constexpr float THR2 = 120.0f;
constexpr float SB_EPS = 7.5e-37f;
constexpr int NWAVES = 8;

#define GAS __attribute__((address_space(1)))
#define LAS __attribute__((address_space(3)))
typedef unsigned short bf16;
typedef unsigned v4u __attribute__((ext_vector_type(4)));
typedef unsigned v2u __attribute__((ext_vector_type(2)));
typedef float f32x4 __attribute__((ext_vector_type(4)));
typedef float f32x16 __attribute__((ext_vector_type(16)));
typedef short bf16x8 __attribute__((ext_vector_type(8)));
typedef short s16x4 __attribute__((ext_vector_type(4)));
#define RLX_AGENT __ATOMIC_RELAXED, __HIP_MEMORY_SCOPE_AGENT
#define LDS_WAIT() asm volatile("s_waitcnt lgkmcnt(0)" ::: "memory")
__device__ __forceinline__ unsigned f2bf(float f) { unsigned u = __builtin_bit_cast(unsigned, f); return (u + 0x7fffu + ((u >> 16) & 1u)) >> 16; }
__device__ __forceinline__ unsigned pk2(float lo, float hi) { return f2bf(lo) | (f2bf(hi) << 16); }
__device__ __forceinline__ unsigned cvtpk(float lo, float hi) { unsigned r; asm volatile("v_cvt_pk_bf16_f32 %0, %1, %2" : "=v"(r) : "v"(lo), "v"(hi)); return r; }
__device__ __forceinline__ float ex2(float x) { return __builtin_amdgcn_exp2f(x); }
__device__ __forceinline__ float lg2(float x) { return __builtin_amdgcn_logf(x); }

constexpr size_t MiB = 1u << 20;
constexpr size_t WS_CTL = 0, CTL_ZERO_BYTES = 64 * 1024;
constexpr size_t WS_SSQ = 1 * MiB;
constexpr size_t WS_WF = 1 * MiB + 6 * 256 * 1024;
constexpr size_t WS_LS2 = 3 * MiB;
constexpr size_t WS_TT = 128 * 1024;
constexpr size_t WS_WQKV0 = 4 * MiB, WS_WO0 = 10 * MiB, WS_WKVQ1 = 12 * MiB, WS_WO1 = 18 * MiB, WS_WGU = 20 * MiB  , WS_WD = 42 * MiB  , WS_WG = 53 * MiB  , WS_WP = 57 * MiB  ;
constexpr size_t WS_HBA = 58 * MiB, WS_HBB = 90 * MiB, WS_Q = 122 * MiB, WS_K = 154 * MiB, WS_V = 186 * MiB, WS_ACT = 122 * MiB  , WS_PBUF0 = WS_HBB  , WS_PBUF1 = WS_WQKV0  , WS_PROJ = 218 * MiB, WS_END = 250 * MiB;
constexpr int CW_BAR = 1024;

constexpr int RING_BYTES = 131072, LDS_BYTES = 163840, MISC_OFF = LDS_BYTES - 256;

#define XB_TMO      128
#define XB_XCNT(j)  (256  + 64 * (j))
#define XB_XSUB(j)  (1280 + 64 * (j))
#define XB_XGEN(j)  (2304 + 64 * (j))
#define XB_TOP      3328
#define XB_TOPGEN   3392
#define XCD_BAR_WORDS 3456
#define XB_SPIN_CAP (1u << 18)

__device__ __forceinline__ unsigned xb_ld(unsigned* p)              { return __hip_atomic_load(p, __ATOMIC_RELAXED, __HIP_MEMORY_SCOPE_AGENT); }
__device__ __forceinline__ unsigned xb_add(unsigned* p, unsigned v) { return __hip_atomic_fetch_add(p, v, __ATOMIC_RELAXED, __HIP_MEMORY_SCOPE_AGENT); }
__device__ __forceinline__ unsigned xb_xcc_id() { return (unsigned)__builtin_amdgcn_s_getreg((3 << 11) | 20) & 0xFu; }
#define XB_SPIN(cond, bar) do { unsigned _sp = 0; while (cond) { __builtin_amdgcn_s_sleep(1); \
    if ((++_sp & 255u) == 0u) { if (xb_ld(&(bar)[XB_TMO])) break; if (_sp > XB_SPIN_CAP) { atomicAdd(&(bar)[XB_TMO], 1u); break; } } } } while (0)

struct XcdBarrier {
    unsigned* bar; unsigned x;
    volatile LAS unsigned* st;
};

__device__ __forceinline__ XcdBarrier xcd_barrier_post(unsigned* bar, volatile LAS unsigned* st) {
    XcdBarrier b; b.bar = bar; b.x = xb_xcc_id(); b.st = st;
    if (threadIdx.x == 0) (void)xb_add(&bar[XB_XCNT(b.x)], 1u);
    return b;
}
__device__ __forceinline__ void xcd_barrier_complete(unsigned* bar, unsigned x, unsigned& nloc, unsigned& nx) {
    const unsigned G = gridDim.x * gridDim.y * gridDim.z;
    unsigned sum, cnt, mine, sp = 0u;
    for (;;) {
        sum = 0u; cnt = 0u; mine = 0u;
#pragma unroll
        for (unsigned j = 0; j < 16; ++j) { const unsigned c = xb_ld(&bar[XB_XCNT(j)]); sum += c; cnt += (c > 0u) ? 1u : 0u; mine = (j == x) ? c : mine; }
        if (sum == G) break;
        __builtin_amdgcn_s_sleep(1);
        if ((++sp & 255u) == 0u) { if (xb_ld(&bar[XB_TMO])) break; if (sp > XB_SPIN_CAP) { atomicAdd(&bar[XB_TMO], 1u); break; } }
    }
    nloc = mine > 0u ? mine : 1u; nx = cnt > 0u ? cnt : 1u;
}

__device__ __forceinline__ void xcd_barrier(const XcdBarrier& b) {
    asm volatile("s_waitcnt vmcnt(0)" ::: "memory");
    __syncthreads();
    if (threadIdx.x == 0) {
        unsigned* bar = b.bar;
        __builtin_amdgcn_s_waitcnt(0);
        unsigned nloc = b.st[0], nx = b.st[1];
        if (nloc == 0u) { xcd_barrier_complete(bar, b.x, nloc, nx); b.st[0] = nloc; b.st[1] = nx; }
        const unsigned old = xb_add(&bar[XB_XSUB(b.x)], 1u);
        const unsigned gen = old / nloc;
        if (old + 1u == (gen + 1u) * nloc) {
            __builtin_amdgcn_fence(__ATOMIC_RELEASE, "agent");
            asm volatile("s_waitcnt vmcnt(0)" ::: "memory");
            const unsigned og = xb_add(&bar[XB_TOP], 1u);
            const unsigned tg = og / nx;
            if (og + 1u == (tg + 1u) * nx) xb_add(&bar[XB_TOPGEN], 1u);
            else XB_SPIN(xb_ld(&bar[XB_TOPGEN]) == tg, bar);
            __builtin_amdgcn_fence(__ATOMIC_ACQUIRE, "agent");
            xb_add(&bar[XB_XGEN(b.x)], 1u);
            asm volatile("s_waitcnt vmcnt(0)" ::: "memory");
        } else {
            XB_SPIN(xb_ld(&bar[XB_XGEN(b.x)]) == gen, bar);
            __builtin_amdgcn_fence(__ATOMIC_ACQUIRE, "agent");
            asm volatile("s_waitcnt vmcnt(0)" ::: "memory");
        }
    }
    __syncthreads();
}

struct TrDesc { const float* W; const float* gain; bf16* WT; int K, ldw, csrc0, nblk, map, item; };
__device__ __forceinline__ void tr_issue(const TrDesc& d, int lane, float (&w)[64]) {
    const int kb = d.item / d.nblk, nb = d.item % d.nblk, k0 = 64 * kb, n = 64 * nb + lane;
    const float* src = d.W + (size_t)k0 * d.ldw + d.csrc0 + n;
#pragma unroll
    for (int i = 0; i < 64; ++i) w[i] = src[(size_t)i * d.ldw];
}
__device__ __forceinline__ void tr_finish(const TrDesc& d, int lane, float (&w)[64]) {
    const int kb = d.item / d.nblk, nb = d.item % d.nblk, k0 = 64 * kb, n = 64 * nb + lane;
    int v = n;
    if (d.map == 1) { const int head = n >> 6, c = n & 63; v = 256 * (head >> 2) + 128 * (c >> 5) + 32 * (head & 3) + (c & 31); }
    else if (d.map == 2) { const int isu = n >= FF, c = isu ? n - FF : n; v = 256 * (c >> 7) + 128 * isu + (c & 127); }
    if (d.gain) {
#pragma unroll
        for (int i = 0; i < 64; ++i) w[i] *= d.gain[k0 + i]; }
    v4u* dst = (v4u*)(d.WT + (size_t)v * d.K + k0);
#pragma unroll
    for (int j = 0; j < 8; ++j) { v4u o; o.x = cvtpk(w[8 * j], w[8 * j + 1]); o.y = cvtpk(w[8 * j + 2], w[8 * j + 3]); o.z = cvtpk(w[8 * j + 4], w[8 * j + 5]); o.w = cvtpk(w[8 * j + 6], w[8 * j + 7]); dst[j] = o; }
}

namespace att {
constexpr int KP = 128, HEAD_BYTES = 2 * 64 * KP, BUF_BYTES = 4 * HEAD_BYTES, GK_OFF = 2 * BUF_BYTES, GQ_OFF = GK_OFF + 2048, FLAG_OFF = GQ_OFF + 1024, ATT_LDS_END = FLAG_OFF + 64;
#define MFMA32(a, b, c) __builtin_amdgcn_mfma_f32_32x32x16_bf16((a), (b), (c), 0, 0, 0)
__device__ __forceinline__ void swap_halves(float v, float& lo, float& hi_) { auto rr = __builtin_amdgcn_permlane32_swap(__float_as_uint(v), __float_as_uint(v), false, false); lo = __uint_as_float(rr[0]); hi_ = __uint_as_float(rr[1]); }

__device__ __forceinline__ void dma_tile(const bf16* Kg, const bf16* Vg, int hg, int j, LAS unsigned char* buf, int wid, int lane) {
    const int kv = 8 * wid + (lane >> 3), ch = (lane & 7) ^ ((lane >> 3) & 7);
    const bf16* kp = Kg + (size_t)(64 * j + kv) * D + hg * 256 + ch * 8; const bf16* vp = Vg + (size_t)(64 * j + kv) * D + hg * 256 + ch * 8;
#pragma unroll
    for (int hl = 0; hl < 4; ++hl) {
        __builtin_amdgcn_global_load_lds((const unsigned*)(kp + hl * 64), (LAS unsigned*)(buf + hl * HEAD_BYTES + wid * 1024), 16, 0, 0);
        __builtin_amdgcn_global_load_lds((const unsigned*)(vp + hl * 64), (LAS unsigned*)(buf + hl * HEAD_BYTES + 64 * KP + wid * 1024), 16, 0, 0); }
}
#define DMA_WAIT() asm volatile("s_waitcnt vmcnt(0)" ::: "memory")
typedef short v4i16_t __attribute__((ext_vector_type(4)));
__device__ __forceinline__ s16x4 vtr(const LAS unsigned char* p) { return __builtin_bit_cast(s16x4, __builtin_amdgcn_ds_read_tr16_b64_v4i16((LAS v4i16_t*)p)); }
__device__ __forceinline__ void qk_tile(f32x16& S0, f32x16& S1, const LAS unsigned char* hb, const bf16x8 (&qf)[4], int r32, int hi) {
    const LAS unsigned char* kb = hb + r32 * KP; const int sw = r32 & 7;
#pragma unroll
    for (int d0 = 0; d0 < 4; ++d0) { const int off = ((2 * d0 + hi) ^ sw) << 4; const bf16x8 a0 = *(const LAS bf16x8*)(kb + off), a1 = *(const LAS bf16x8*)(kb + 32 * KP + off);
        S0 = MFMA32(a0, qf[d0], S0); S1 = MFMA32(a1, qf[d0], S1); }
}
__device__ __forceinline__ void pv_tile(f32x16& o0, f32x16& o1, const LAS unsigned char* hb, const float (&pw)[32], int lane) {
    const int sw = 4 * (lane >> 5) + ((lane & 15) >> 2), c0 = 2 * ((lane >> 4) & 1) + ((lane & 3) >> 1);
    const LAS unsigned char* vb = hb + 64 * KP + sw * KP + (lane & 1) * 8; const int of0 = (c0 ^ sw) << 4, of1 = ((c0 + 4) ^ sw) << 4;
#pragma unroll
    for (int p = 0; p < 2; ++p)
#pragma unroll
        for (int s = 0; s < 2; ++s) { const int o = p * 16 + 8 * s;
            v4u pk; pk.x = cvtpk(pw[o], pw[o + 1]); pk.y = cvtpk(pw[o + 2], pw[o + 3]); pk.z = cvtpk(pw[o + 4], pw[o + 5]); pk.w = cvtpk(pw[o + 6], pw[o + 7]);
            const bf16x8 pb = __builtin_bit_cast(bf16x8, pk);
            const int ro = (32 * p + 16 * s) * KP;
            const s16x4 l0 = vtr(vb + ro + of0), h0 = vtr(vb + ro + 8 * KP + of0), l1 = vtr(vb + ro + of1), h1 = vtr(vb + ro + 8 * KP + of1);
            const bf16x8 a0 = __builtin_shufflevector(l0, h0, 0, 1, 2, 3, 4, 5, 6, 7), a1 = __builtin_shufflevector(l1, h1, 0, 1, 2, 3, 4, 5, 6, 7);
            o0 = MFMA32(a0, pb, o0); o1 = MFMA32(a1, pb, o1); }
}
__device__ __forceinline__ void store_o(bf16* Og, int t0w, int h, const f32x16& o0, const f32x16& o1, float sc, int lane, LAS unsigned char* og) {
    const int r32 = lane & 31, hi = lane >> 5;
    LAS unsigned char* wp = og + r32 * 144 + 8 * hi;
#pragma unroll
    for (int g = 0; g < 4; ++g) { v2u w0, w1; w0.x = cvtpk(o0[4 * g] * sc, o0[4 * g + 1] * sc); w0.y = cvtpk(o0[4 * g + 2] * sc, o0[4 * g + 3] * sc);
        w1.x = cvtpk(o1[4 * g] * sc, o1[4 * g + 1] * sc); w1.y = cvtpk(o1[4 * g + 2] * sc, o1[4 * g + 3] * sc);
        *(LAS v2u*)(wp + 16 * g) = w0; *(LAS v2u*)(wp + 64 + 16 * g) = w1; }
    const int row = lane >> 3, ch = lane & 7; bf16* op = Og + (size_t)(t0w + row) * D + h * DH + ch * 8;
#pragma unroll
    for (int it = 0; it < 4; ++it) { const v4u v = *(const LAS v4u*)(og + (8 * it + row) * 144 + ch * 16); *(v4u*)(op + (size_t)(8 * it) * D) = v; }
}
__device__ __forceinline__ float suffix_scan_excl(float v, int lane, float& total) {
    float inc = v;
#pragma unroll
    for (int off = 1; off < 64; off <<= 1) { const float t = __shfl_down(inc, off); if (lane + off < 64) inc += t; }
    total = __shfl(inc, 0); return inc - v;
}

template <bool FOX, bool CONV> __device__ __forceinline__ void attn_unit(int hg, int qb, const bf16* Qg, const bf16* Kg, const bf16* Vg, bf16* Og, const float* LS2, const float* TTp, float bound2, LAS unsigned char* lds,
                                                                        bool has_cv, const TrDesc& cvd, float (&cvw)[64]) {
    int tid_ = threadIdx.x; asm volatile("" : "+v"(tid_));
    const int tid = tid_, lane = tid & 63, r32 = lane & 31, hi = lane >> 5, wid = __builtin_amdgcn_readfirstlane(tid >> 6);
    const int hl = wid >> 1, h = hg * 4 + hl, t0w = qb * 64 + 32 * (wid & 1), tq = t0w + r32, jmax = qb;
    volatile LAS int* flags = (volatile LAS int*)(lds + FLAG_OFF);
    LAS float* GK = (LAS float*)(lds + GK_OFF); LAS float* GQ = (LAS float*)(lds + GQ_OFF);
    const float* glh = LS2 + (size_t)(hg * 4 + (wid & 3)) * M; const float* tth = TTp + (hg * 4 + (wid & 3)) * 256;
    bf16x8 qf[4];
#pragma unroll
    for (int d0 = 0; d0 < 4; ++d0) qf[d0] = *(const bf16x8*)(Qg + (size_t)tq * D + h * DH + d0 * 16 + hi * 8);
    float gnext = 0.f, tnext = 0.f, cgk = 0.f, ex0 = 0.f;
    if (FOX && wid < 4) { ex0 = glh[64 * jmax + lane]; cgk = tth[jmax]; }
    f32x16 o0 = {}, o1 = {}; float carry = 1.f, mrun = -INFINITY, lsum = 0.f; bool wdone = false;
    __syncthreads();
    dma_tile(Kg, Vg, hg, jmax, lds, wid, lane);
    if (tid < 16) flags[tid] = 0;
    if (FOX && wid < 4) { GK[wid * 64 + lane] = ex0; GQ[wid * 64 + lane] = ex0; }
    if (CONV && has_cv) { tr_issue(cvd, lane, cvw); asm volatile("s_waitcnt vmcnt(63) lgkmcnt(0)" ::: "memory"); }
    else asm volatile("s_waitcnt vmcnt(0) lgkmcnt(0)" ::: "memory");
    __builtin_amdgcn_s_barrier(); asm volatile("" ::: "memory");
    float gq = 0.f, gq0 = 0.f; if (FOX) { gq = GQ[hl * 64 + (wid & 1) * 32 + r32]; gq0 = GQ[hl * 64 + (wid & 1) * 32]; }
    for (int j = jmax, it = 0;; --j, ++it) {
        const int b = it & 1; const LAS unsigned char* hb = lds + b * BUF_BYTES + hl * HEAD_BYTES; const LAS float* gkb = GK + b * 256 + hl * 64;
        if (it > 0) { int nd = 0;
#pragma unroll
            for (int w = 0; w < 8; ++w) nd += flags[((it - 1) & 1) * 8 + w];
            if (nd == 8) break; }
        const bool have_next = j > 0;
        if (have_next) { dma_tile(Kg, Vg, hg, j - 1, lds + (b ^ 1) * BUF_BYTES, wid, lane); if (FOX && wid < 4) { gnext = glh[64 * (j - 1) + lane]; tnext = tth[j - 1]; } }
        if (!wdone) {
            const bool need_mask = (j == jmax);
            if (!FOX) {
                f32x16 S0 = {}, S1 = {};
                qk_tile(S0, S1, hb, qf, r32, hi);
                float be[32], om[32];
#pragma unroll
                for (int p = 0; p < 2; ++p)
#pragma unroll
                    for (int i = 0; i < 16; ++i) { const float z = fmaxf(p ? S1[i] : S0[i], -100.f);
                        const float t = ex2(-z), bt = __builtin_amdgcn_rcpf(1.f + t);
                        be[p * 16 + i] = bt; om[p * 16 + i] = t * bt; }
                if (need_mask) {
#pragma unroll
                    for (int p = 0; p < 2; ++p)
#pragma unroll
                        for (int i = 0; i < 16; ++i) { const int kv = 64 * j + 32 * p + (i & 3) + 8 * (i >> 2) + 4 * hi; const bool ok = kv < tq;
                            be[p * 16 + i] = ok ? be[p * 16 + i] : 0.f; om[p * 16 + i] = ok ? om[p * 16 + i] : 1.f; } }
                float base = carry;
#pragma unroll
                for (int p = 1; p >= 0; --p)
#pragma unroll
                    for (int g = 3; g >= 0; --g) { const int o = p * 16 + 4 * g;
                        const float q2 = om[o + 3], q1 = q2 * om[o + 2], q0 = q1 * om[o + 1], G = q0 * om[o];
                        float Glo, Ghi; swap_halves(G, Glo, Ghi);
                        const float bl = base * (hi ? 1.f : Ghi);
                        be[o + 3] *= bl; be[o + 2] *= bl * q2; be[o + 1] *= bl * q1; be[o] *= bl * q0;
                        base *= Glo * Ghi; }
                carry = base;
                pv_tile(o0, o1, hb, be, lane);
                wdone = __all(carry < SB_EPS);
            } else {
                if (__all(gkb[63] - gq + bound2 - mrun < -THR2)) wdone = true;
                else {
                    f32x16 S0 = {}, S1 = {};
                    qk_tile(S0, S1, hb, qf, r32, hi);
                    float x[32]; float tmax = -INFINITY;
#pragma unroll
                    for (int p = 0; p < 2; ++p)
#pragma unroll
                        for (int g = 0; g < 4; ++g) { const f32x4 gk4 = *(const LAS f32x4*)(gkb + 32 * p + 8 * g + 4 * hi);
#pragma unroll
                            for (int e = 0; e < 4; ++e) { const int i = 4 * g + e; const float z = p ? S1[i] : S0[i];
                                const int kv = 64 * j + 32 * p + 8 * g + 4 * hi + e;
                                float v = z + (gk4[e] - gq);
                                if (need_mask && kv > tq) v = -INFINITY;
                                x[p * 16 + i] = v; tmax = fmaxf(tmax, v); } }
                    float tl, th; swap_halves(tmax, tl, th); tmax = fmaxf(tl, th);
                    const float mnew = fmaxf(mrun, tmax), alpha = ex2(mrun - mnew); mrun = mnew;
                    float ps = 0.f;
#pragma unroll
                    for (int i = 0; i < 32; ++i) { x[i] = ex2(x[i] - mnew); ps += x[i]; }
                    lsum = lsum * alpha + ps;
                    if (!__all(alpha == 1.0f)) {
#pragma unroll
                        for (int i = 0; i < 16; ++i) { o0[i] *= alpha; o1[i] *= alpha; } }
                    pv_tile(o0, o1, hb, x, lane);
                }
            }
        }
        if (lane == 0) flags[b * 8 + wid] = wdone ? 1 : 0;
        if (have_next && FOX && wid < 4) { GK[(b ^ 1) * 256 + wid * 64 + lane] = cgk + gnext; cgk += tnext; }
        DMA_WAIT(); __syncthreads();
        if (!have_next) break;
    }
    float sc = 1.f;
    if (FOX) { float ll, lh; swap_halves(lsum, ll, lh); sc = __builtin_amdgcn_rcpf(ll + lh); }
    store_o(Og, t0w, h, o0, o1, sc, lane, lds + wid * 4608);
}
#undef MFMA32
}

struct Frame { LAS unsigned char* lds; int tid, lane, wave, vcu, G; };
__device__ __forceinline__ float wave_sum(float v) {
#pragma unroll
    for (int o = 1; o < 64; o <<= 1) v += __shfl_xor(v, o);
    return v;
}
__device__ __forceinline__ float wave_max(float v) {
#pragma unroll
    for (int o = 1; o < 64; o <<= 1) v = fmaxf(v, __shfl_xor(v, o));
    return v;
}
template <int MAP> __device__ __forceinline__ void tr_item(const float* W, int K, int ldw, int csrc0, int nblk, const float* gain, bf16* WT, int item, int lane) {
    const int kb = item / nblk, nb = item % nblk, k0 = 64 * kb, n = 64 * nb + lane;
    int v;
    if (MAP == 0) v = n;
    else if (MAP == 1) { const int head = n >> 6, c = n & 63; v = 256 * (head >> 2) + 128 * (c >> 5) + 32 * (head & 3) + (c & 31); }
    else { const int isu = n >= FF, c = isu ? n - FF : n; v = 256 * (c >> 7) + 128 * isu + (c & 127); }
    const float* src = W + (size_t)k0 * ldw + csrc0 + n;
    float w[64];
#pragma unroll
    for (int i = 0; i < 64; ++i) w[i] = src[(size_t)i * ldw];
    if (gain) {
#pragma unroll
        for (int i = 0; i < 64; ++i) w[i] *= gain[k0 + i]; }
    v4u* dst = (v4u*)(WT + (size_t)v * K + k0);
#pragma unroll
    for (int j = 0; j < 8; ++j) { v4u o; o.x = cvtpk(w[8 * j], w[8 * j + 1]); o.y = cvtpk(w[8 * j + 2], w[8 * j + 3]); o.z = cvtpk(w[8 * j + 4], w[8 * j + 5]); o.w = cvtpk(w[8 * j + 6], w[8 * j + 7]); dst[j] = o; }
}


struct Args { const float* in[18]; float* out; unsigned char* ws; };
typedef const __attribute__((address_space(4))) Args* ArgsP;
__device__ __forceinline__ ArgsP argp() { ArgsP p = (ArgsP)__builtin_amdgcn_kernarg_segment_ptr(); asm volatile("" : "+s"(p)); return p; }
#define WSP(T, off) ((T*)(A->ws + (off)))
enum { IN_X = 0, IN_P, IN_ATTN_G, IN_SB_WQKV, IN_SB_WO, IN_SHARED_G, IN_WKVF, IN_BF, IN_KNORM_G, IN_FOX_WQ, IN_QNORM_G, IN_FOX_WO, IN_FFN_G, IN_WGU, IN_WD, IN_PLE_G, IN_WGATE, IN_WPROJ };

__device__ __forceinline__ void convert_p(const Frame& F, const float* psrc, bf16* pdst) {
    const int gw = F.vcu * NWAVES + F.wave, NGW = F.G * NWAVES; const f32x4* ps = (const f32x4*)psrc; v2u* pd = (v2u*)pdst;
    for (int i = gw * 64 + F.lane; i < M * PLE / 4; i += NGW * 64) { const f32x4 v = ps[i]; v2u w; w.x = pk2(v.x, v.y); w.y = pk2(v.z, v.w); pd[i] = w; }
}

template <int PART> __device__ __forceinline__ void prologue(const Frame& F) {
    ArgsP A = argp();
    const int gw = F.wave * F.G + F.vcu, NGW = F.G * NWAVES;
    constexpr int I0 = 16 * 48, I1 = 256, I2 = 256, I3 = 256, I4 = 256, I5 = 256, I6 = 16 * 88, I7 = 44 * 16, I8 = 256, I9 = 4 * 16;
    constexpr int NITEMS = I0 + I1 + I2 + I3 + I4 + I5 + 2 * I6 + 2 * I7 + 2 * I8 + 2 * I9;
    constexpr int N1 = I1 + I6 + I7 + I8 + I9, N2 = I2 + I3 + I4 + I5 + I6 + I7 + I8 + I9; static_assert(I0 + N1 + N2 == NITEMS, "item count");
    for (int it = gw; it < (PART == 0 ? I0 : PART == 1 ? N1 : N2); it += NGW) {
        int r = it;
        if (PART == 0) { tr_item<0>(A->in[IN_SB_WQKV], D, 3 * D, 0, 48, A->in[IN_ATTN_G], WSP(bf16, WS_WQKV0), r, F.lane); continue; }
        if (PART == 1) { if (r < I1) { tr_item<0>(A->in[IN_SB_WO], D, D, 0, 16, nullptr, WSP(bf16, WS_WO0), r, F.lane); continue; } r -= I1; }
        else {
            if (r < I2) { tr_item<1>(A->in[IN_WKVF], D, 2 * D + NH, 0, 16, A->in[IN_SHARED_G], WSP(bf16, WS_WKVQ1), r, F.lane); continue; } r -= I2;
            if (r < I3) { tr_item<1>(A->in[IN_WKVF], D, 2 * D + NH, D, 16, A->in[IN_SHARED_G], WSP(bf16, WS_WKVQ1) + (size_t)D * D, r, F.lane); continue; } r -= I3;
            if (r < I4) { tr_item<1>(A->in[IN_FOX_WQ], D, D, 0, 16, A->in[IN_ATTN_G] + D, WSP(bf16, WS_WKVQ1) + (size_t)2 * D * D, r, F.lane); continue; } r -= I4;
            if (r < I5) { tr_item<0>(A->in[IN_FOX_WO], D, D, 0, 16, nullptr, WSP(bf16, WS_WO1), r, F.lane); continue; } r -= I5; }
        constexpr int l = PART == 1 ? 0 : 1;
        if (r < I6) { tr_item<2>(A->in[IN_WGU] + (size_t)l * D * 2 * FF, D, 2 * FF, 0, 88, A->in[IN_FFN_G] + l * D, WSP(bf16, WS_WGU) + (size_t)l * 2 * FF * D, r, F.lane); continue; } r -= I6;
        if (r < I7) { tr_item<0>(A->in[IN_WD] + (size_t)l * FF * D, FF, D, 0, 16, nullptr, WSP(bf16, WS_WD) + (size_t)l * D * FF, r, F.lane); continue; } r -= I7;
        if (r < I8) { tr_item<0>(A->in[IN_WGATE] + (size_t)l * D * D, D, D, 0, 16, A->in[IN_PLE_G] + l * D, WSP(bf16, WS_WG) + (size_t)l * D * D, r, F.lane); continue; } r -= I8;
        tr_item<0>(A->in[IN_WPROJ] + (size_t)l * PLE * D, PLE, D, 0, 16, nullptr, WSP(bf16, WS_WP) + (size_t)l * D * PLE, r, F.lane);
    }
    if (PART == 2) { const float* wk = A->in[IN_WKVF]; const float* sg = A->in[IN_SHARED_G]; bf16* WF = WSP(bf16, WS_WF);
      for (int i = gw * 64 + F.lane; i < NH * D; i += NGW * 64) { const int n = i >> 10, k = i & 1023; WF[i] = (bf16)f2bf(wk[(size_t)k * (2 * D + NH) + 2 * D + n] * sg[k]); } }
    if (PART == 0) { const float* x = A->in[IN_X]; bf16* HBA = WSP(bf16, WS_HBA); float* SSQ = WSP(float, WS_SSQ);
      for (int m0 = gw * 4; m0 < M; m0 += NGW * 4) {
        f32x4 v[4][4];
#pragma unroll
        for (int r = 0; r < 4; ++r) { const f32x4* xr = (const f32x4*)(x + (size_t)(m0 + r) * D) + F.lane;
#pragma unroll
            for (int j = 0; j < 4; ++j) v[r][j] = xr[64 * j]; }
#pragma unroll
        for (int r = 0; r < 4; ++r) { float s = 0.f;
#pragma unroll
            for (int j = 0; j < 4; ++j) s += (v[r][j].x * v[r][j].x + v[r][j].y * v[r][j].y) + (v[r][j].z * v[r][j].z + v[r][j].w * v[r][j].w);
            s = wave_sum(s);
            v2u* o8 = (v2u*)(HBA + (size_t)(m0 + r) * D) + F.lane;
#pragma unroll
            for (int j = 0; j < 4; ++j) { v2u w; w.x = cvtpk(v[r][j].x, v[r][j].y); w.y = cvtpk(v[r][j].z, v[r][j].w); o8[64 * j] = w; }
            if (F.lane == 0) *(f32x4*)(SSQ + (size_t)(m0 + r) * 4) = (f32x4){s, 0.f, 0.f, 0.f}; }
      } }
}

#ifdef TSTAMP_A
#define TSTAMP(i) do { if (blockIdx.x == 0 && F.tid == 0) { ArgsP A_ = argp(); ((unsigned long long*)(A_->ws + 49152))[(i)] = __builtin_amdgcn_s_memrealtime(); } } while (0)
#else
#define TSTAMP(i) do {} while (0)
#endif

constexpr int CV_I1 = 256, CV_I6 = 16 * 88, CV_I7 = 44 * 16, CV_I8 = 256, CV_I9 = 4 * 16, CV_N1 = CV_I1 + CV_I6 + CV_I7 + CV_I8 + CV_I9, CV_N2 = 4 * 256 + CV_I6 + CV_I7 + CV_I8 + CV_I9, CV_N = CV_N1 + CV_N2;
__device__ __forceinline__ TrDesc cv_decode(int r) {
    ArgsP A = argp(); TrDesc d; d.gain = nullptr; d.K = D; d.ldw = D; d.csrc0 = 0; d.nblk = 16; d.map = 0;
    int l = 0;
    if (r >= CV_N1) { r -= CV_N1; l = 1;
        if (r < 256) { d.W = A->in[IN_WKVF]; d.ldw = 2 * D + NH; d.gain = A->in[IN_SHARED_G]; d.WT = WSP(bf16, WS_WKVQ1); d.map = 1; d.item = r; return d; } r -= 256;
        if (r < 256) { d.W = A->in[IN_WKVF]; d.ldw = 2 * D + NH; d.csrc0 = D; d.gain = A->in[IN_SHARED_G]; d.WT = WSP(bf16, WS_WKVQ1) + (size_t)D * D; d.map = 1; d.item = r; return d; } r -= 256;
        if (r < 256) { d.W = A->in[IN_FOX_WQ]; d.gain = A->in[IN_ATTN_G] + D; d.WT = WSP(bf16, WS_WKVQ1) + (size_t)2 * D * D; d.map = 1; d.item = r; return d; } r -= 256;
        if (r < 256) { d.W = A->in[IN_FOX_WO]; d.WT = WSP(bf16, WS_WO1); d.item = r; return d; } r -= 256;
    } else { if (r < CV_I1) { d.W = A->in[IN_SB_WO]; d.WT = WSP(bf16, WS_WO0); d.item = r; return d; } r -= CV_I1; }
    if (r < CV_I6) { d.W = A->in[IN_WGU] + (size_t)l * D * 2 * FF; d.ldw = 2 * FF; d.nblk = 88; d.gain = A->in[IN_FFN_G] + l * D; d.WT = WSP(bf16, WS_WGU) + (size_t)l * 2 * FF * D; d.map = 2; d.item = r; return d; } r -= CV_I6;
    if (r < CV_I7) { d.W = A->in[IN_WD] + (size_t)l * FF * D; d.K = FF; d.WT = WSP(bf16, WS_WD) + (size_t)l * D * FF; d.item = r; return d; } r -= CV_I7;
    if (r < CV_I8) { d.W = A->in[IN_WGATE] + (size_t)l * D * D; d.gain = A->in[IN_PLE_G] + l * D; d.WT = WSP(bf16, WS_WG) + (size_t)l * D * D; d.item = r; return d; } r -= CV_I8;
    d.W = A->in[IN_WPROJ] + (size_t)l * PLE * D; d.K = PLE; d.WT = WSP(bf16, WS_WP) + (size_t)l * D * PLE; d.item = r; return d;
}

template <int L> __device__ __forceinline__ void layer(const Frame& F, const XcdBarrier& bar) {
    constexpr size_t SSQ_A = WS_SSQ + (size_t)(3 * L) * M * 16, SSQ_B = WS_SSQ + (size_t)(3 * L + 1) * M * 16, SSQ_C = WS_SSQ + (size_t)(3 * L + 2) * M * 16, SSQ_D = WS_SSQ + (size_t)(3 * L + 3) * M * 16;
    if (L == 0) {
        ArgsP A = argp();
        pg8::Gemm g{WSP(bf16, WS_HBA), WSP(bf16, WS_WQKV0), M, 3 * D, D}; pg8::StaticOrder S; S.init(M, 3 * D, F.G, (int)blockIdx.x);
        pg8::EpiQKV0 E{WSP(bf16, WS_Q), (size_t)M * D, WSP(float, SSQ_A), QSCALE};
        pg8::gemm_phase<pg8::EpiQKV0, pg8::StaticOrder, true, true>(F.lds, g, S, E);
    } else {
        { ArgsP A = argp(); const bf16* HBB = WSP(bf16, WS_HBB); const bf16* WF = WSP(bf16, WS_WF); float* GL = WSP(float, WS_LS2); float* TT = WSP(float, WS_TT); const float* ssq = WSP(float, SSQ_A); const float* b_f = A->in[IN_BF];
          LAS float* T = (LAS float*)F.lds;
          for (int rb = blockIdx.x; rb < M / 64; rb += F.G) {
            if (F.wave < 4) { const int fr = F.lane & 15, fq = F.lane >> 4, row0 = rb * 64 + F.wave * 16;
                const bf16* ap = HBB + (size_t)(row0 + fr) * D + 8 * fq; const bf16* bp = WF + (size_t)fr * D + 8 * fq;
                f32x4 acc = {0.f, 0.f, 0.f, 0.f};
#pragma unroll 16
                for (int kk = 0; kk < 32; ++kk) { const bf16x8 a = *(const bf16x8*)(ap + kk * 32), b = *(const bf16x8*)(bp + kk * 32); acc = __builtin_amdgcn_mfma_f32_16x16x32_bf16(a, b, acc, 0, 0, 0); }
                const float bias = b_f[fr]; f32x4 o;
#pragma unroll
                for (int i = 0; i < 4; ++i) { const float f2 = (acc[i] * pg8::row_rinv(ssq, row0 + 4 * fq + i) + bias) * LOG2E_F;
                    o[i] = -(fmaxf(-f2, 0.f) + lg2(1.f + ex2(-fabsf(f2)))); }
                *(LAS f32x4*)(T + fr * 64 + F.wave * 16 + 4 * fq) = o; }
            __syncthreads();
#pragma unroll
            for (int hh = 0; hh < 2; ++hh) { const int hd = 2 * F.wave + hh; float tot; const float ex = att::suffix_scan_excl(T[hd * 64 + F.lane], F.lane, tot);
                GL[(size_t)hd * M + rb * 64 + F.lane] = ex; if (F.lane == 0) TT[hd * 256 + rb] = tot; }
            __syncthreads();
          } }
        ArgsP A = argp();
        pg8::Gemm g{WSP(bf16, WS_HBB), WSP(bf16, WS_WKVQ1), M, 3 * D, D}; pg8::StaticOrder S; S.init(M, 3 * D, F.G, (int)blockIdx.x);
        pg8::EpiKVQ1 E{WSP(bf16, WS_Q), (size_t)M * D, WSP(float, SSQ_A), A->in[IN_KNORM_G], A->in[IN_QNORM_G], QSCALE};
        pg8::gemm_phase<pg8::EpiKVQ1, pg8::StaticOrder, true, true>(F.lds, g, S, E);
    }
    xcd_barrier(bar); TSTAMP(2 + 6 * L);
    {
        ArgsP A = argp();
        float bound2 = 0.f;
        if (L == 1) { const float mq = wave_max(fabsf(A->in[IN_QNORM_G][F.lane])), mk = wave_max(fabsf(A->in[IN_KNORM_G][F.lane])); bound2 = 1.02f * 8.0f * LOG2E_F * mq * mk; }
        bf16* QB = WSP(bf16, WS_Q); const bf16* KB = WSP(bf16, WS_K); const bf16* VB = WSP(bf16, WS_V); const float* LS2 = WSP(float, WS_LS2); const float* TT = WSP(float, WS_TT);
#ifdef REP_ATT
        if (L == REP_ATT - 1) { bf16* DUMMY = WSP(bf16, WS_PROJ);
          for (int un = F.vcu; un < 4 * (M / 64); un += F.G) { const int hg = un >> 8, qb = un & 255;
            { TrDesc d0; float w0[64]; if (L == 0) att::attn_unit<false, false>(hg, qb, QB, KB, VB, DUMMY, LS2, TT, 0.f, F.lds, false, d0, w0);
            else att::attn_unit<true, false>(hg, qb, QB, KB, VB, DUMMY, LS2, TT, bound2, F.lds, false, d0, w0); } }
          __syncthreads(); xcd_barrier(bar); }
#endif
        if (!(blockIdx.x & 1)) convert_p(F, A->in[IN_P] + (size_t)L * M * PLE, WSP(bf16, L == 0 ? WS_PBUF0 : WS_PBUF1));
        if (L == 0) {
            int cit = F.wave * F.G + F.vcu; const int NGW = F.G * NWAVES;
            for (int un = F.vcu; un < 4 * (M / 64); un += F.G) { const int hg = un >> 8, qb = un & 255;
                const bool has = cit < CV_N; TrDesc d; float w[64];
                if (has) d = cv_decode(cit);
                att::attn_unit<false, true>(hg, qb, QB, KB, VB, QB, LS2, TT, 0.f, F.lds, has, d, w);
                if (has) tr_finish(d, F.lane, w);
                cit += NGW; }
            for (; cit < CV_N; cit += NGW) { TrDesc d = cv_decode(cit); float w[64]; tr_issue(d, F.lane, w); tr_finish(d, F.lane, w); }
            { const float* wk = A->in[IN_WKVF]; const float* sg = A->in[IN_SHARED_G]; bf16* WF = WSP(bf16, WS_WF); const int gw = F.wave * F.G + F.vcu;
              for (int i = gw * 64 + F.lane; i < NH * D; i += NGW * 64) { const int n = i >> 10, k = i & 1023; WF[i] = (bf16)f2bf(wk[(size_t)k * (2 * D + NH) + 2 * D + n] * sg[k]); } }
        } else {
            for (int un = F.vcu; un < 4 * (M / 64); un += F.G) { const int hg = un >> 8, qb = un & 255;
                { TrDesc d0; float w0[64]; att::attn_unit<true, false>(hg, qb, QB, KB, VB, QB, LS2, TT, bound2, F.lds, false, d0, w0); } }
        }
        if (blockIdx.x & 1) convert_p(F, A->in[IN_P] + (size_t)L * M * PLE, WSP(bf16, L == 0 ? WS_PBUF0 : WS_PBUF1));
        __syncthreads();
    }
    xcd_barrier(bar); TSTAMP(3 + 6 * L);
#ifdef REP_WO
    for (int rep_ = 0; rep_ < 1 + (L == 0 ? REP_WO : 0); ++rep_) { if (rep_) xcd_barrier(bar);
#else
    {
#endif
    for (int idx = blockIdx.x; idx < 256; idx += F.G) {
        ArgsP A = argp();
        pg8::StaticOrder S0; S0.init(M, D, 256, idx); pg8::OneUnit S; S0.next(0, S.u);
        pg8::Gemm g{WSP(bf16, WS_Q), WSP(bf16, L == 0 ? WS_WO0 : WS_WO1), M, D, D};
        pg8::EpiRes<false> E{L == 0 ? (const void*)WSP(bf16, WS_HBA) : (const void*)WSP(bf16, WS_HBB), WSP(bf16, WS_HBA), WSP(float, SSQ_B)};
        pg8::gemm_phase<pg8::EpiRes<false>, pg8::OneUnit, false, true>(F.lds, g, S, E);
    }
    }
    xcd_barrier(bar); TSTAMP(4 + 6 * L);
#ifdef REP_GU
    for (int rep_ = 0; rep_ < 1 + (L == 0 ? REP_GU : 0); ++rep_) { if (rep_) xcd_barrier(bar);
#else
    {
#endif
    {
        ArgsP A = argp();
        pg8::Gemm g{WSP(bf16, WS_HBA), WSP(bf16, WS_WGU) + (size_t)L * 2 * FF * D, M, 2 * FF, D}; pg8::StaticOrder S; S.init(M, 2 * FF, F.G, (int)blockIdx.x);
        pg8::EpiGU E{WSP(bf16, WS_ACT), WSP(float, SSQ_B)};
        pg8::gemm_phase<pg8::EpiGU, pg8::StaticOrder, true, true>(F.lds, g, S, E);
    }
    { const int rem = ((M / 256) * (2 * FF / 256)) % F.G, nlight = F.G - rem, lb = (int)blockIdx.x - rem;
      if (lb >= 0) for (int pu = lb; pu < 256; pu += nlight) {
        ArgsP A = argp(); pg8::StaticOrder S0; S0.init(M, D, 256, pu); pg8::OneUnit S; S0.next(0, S.u);
        pg8::Gemm g{WSP(bf16, L == 0 ? WS_PBUF0 : WS_PBUF1), WSP(bf16, WS_WP) + (size_t)L * D * PLE, M, D, PLE}; pg8::EpiProj E{WSP(bf16, WS_PROJ)};
        pg8::gemm_phase<pg8::EpiProj, pg8::OneUnit, false, true>(F.lds, g, S, E); } }
    }
    xcd_barrier(bar); TSTAMP(5 + 6 * L);
    for (int idx = blockIdx.x; idx < 256; idx += F.G) {
        ArgsP A = argp();
        pg8::StaticOrder S0; S0.init(M, D, 256, idx); pg8::OneUnit S; S0.next(0, S.u);
        pg8::Gemm g{WSP(bf16, WS_ACT), WSP(bf16, WS_WD) + (size_t)L * D * FF, M, D, FF};
        pg8::EpiRes<false> E{(const void*)WSP(bf16, WS_HBA), WSP(bf16, WS_HBA), WSP(float, SSQ_C)};
        pg8::gemm_phase<pg8::EpiRes<false>, pg8::OneUnit, false, true>(F.lds, g, S, E);
    }
    xcd_barrier(bar); TSTAMP(6 + 6 * L);
#ifdef REP_PLE
    for (int rep_ = 0; rep_ < 1 + (L == 0 ? REP_PLE : 0); ++rep_) { if (rep_) xcd_barrier(bar);
#else
    {
#endif
    for (int idx = blockIdx.x; idx < 256; idx += F.G) {
        pg8::StaticOrder S0; S0.init(M, D, 256, idx); pg8::OneUnit S; S0.next(0, S.u);
        { ArgsP A = argp(); pg8::Gemm g{WSP(bf16, WS_HBA), WSP(bf16, WS_WG) + (size_t)L * D * D, M, D, D};
          pg8::EpiPle E{WSP(float, SSQ_C), WSP(bf16, WS_HBA), WSP(bf16, WS_PROJ), L == 0 ? WSP(bf16, WS_HBB) : (bf16*)nullptr, L == 0 ? (float*)nullptr : A->out, L == 0 ? WSP(float, SSQ_D) : (float*)nullptr};
          pg8::gemm_phase<pg8::EpiPle, pg8::OneUnit, false, true>(F.lds, g, S, E); }
    }
    }
    if (L == 0) { xcd_barrier(bar); TSTAMP(7);
    }
#ifdef TSTAMP_A
    if (L == 1) { xcd_barrier(bar); TSTAMP(13); xcd_barrier(bar);
        ArgsP A = argp(); const unsigned long long* st = (const unsigned long long*)(A->ws + 49152);
        const float d = (float)(st[TSTAMP_A] - st[TSTAMP_A - 1]); const float dl = 0.05f * sqrtf(d * 1e-4f);
        for (int i = blockIdx.x * 512 + F.tid; i < 65536; i += F.G * 512) A->out[4096 + i] += (i & 1) ? dl : -dl; }
#endif
}

__global__ void __launch_bounds__(NWAVES * 64, 2) mega_fwd(Args args) {
    extern __shared__ __attribute__((aligned(16))) unsigned char lds_raw[];
    Frame F;
    F.lds = (LAS unsigned char*)lds_raw;
    F.tid = threadIdx.x; F.lane = F.tid & 63; F.wave = __builtin_amdgcn_readfirstlane(F.tid >> 6);
    F.G = gridDim.x; { const int bx = blockIdx.x; F.vcu = (F.G % 8 == 0) ? (bx % 8) * (F.G / 8) + bx / 8 : bx; }
    volatile LAS unsigned* MISC = (volatile LAS unsigned*)(F.lds + MISC_OFF);
    for (int u = F.tid; u < (LDS_BYTES - RING_BYTES) / 4; u += NWAVES * 64) ((LAS unsigned*)(F.lds + RING_BYTES))[u] = 0u;
    __syncthreads();
    XcdBarrier bar;
    { ArgsP A = argp(); bar = xcd_barrier_post(WSP(unsigned, WS_CTL) + CW_BAR, MISC + 8); }
    TSTAMP(0);
#ifdef REP_PRO
    for (int rep_ = 0; rep_ < REP_PRO; ++rep_) { prologue<0>(F); xcd_barrier(bar); }
#endif
    prologue<0>(F);
    if (gridDim.y == 0x7fffu) cg::this_grid().sync();
    xcd_barrier(bar); TSTAMP(1);
    layer<0>(F, bar);
    layer<1>(F, bar);
    (void)args;
}

extern "C" void kernel_launch(void* const* d_in, const int* in_sizes, int n_in, void* d_out, int out_size, void* d_ws, size_t ws_size, hipStream_t stream) {
    static int grid = 0;
    if (grid == 0) {
        if (n_in != 18 || in_sizes[0] != M * D || out_size != M * D || ws_size < WS_END) { fprintf(stderr, "kernel_launch: unexpected shapes (n_in %d, in0 %d, out %d, ws %zu); nothing launched\n", n_in, n_in > 0 ? in_sizes[0] : -1, out_size, ws_size); grid = -1; return; }
        int dev = 0, cus = 0, per_cu = 0;
        if (hipGetDevice(&dev) != hipSuccess || hipDeviceGetAttribute(&cus, hipDeviceAttributeMultiprocessorCount, dev) != hipSuccess) { fprintf(stderr, "kernel_launch: device query failed\n"); grid = -1; return; }
        if (hipFuncSetAttribute((const void*)mega_fwd, hipFuncAttributeMaxDynamicSharedMemorySize, LDS_BYTES) != hipSuccess) { fprintf(stderr, "kernel_launch: hipFuncSetAttribute failed\n"); grid = -1; return; }
        if (hipOccupancyMaxActiveBlocksPerMultiprocessor(&per_cu, (const void*)mega_fwd, NWAVES * 64, LDS_BYTES) != hipSuccess || per_cu < 1) { fprintf(stderr, "kernel_launch: occupancy query says %d\n", per_cu); per_cu = 1; }
        (void)hipGetLastError();
        grid = cus * per_cu;
    }
    if (grid < 0) return;
    if (hipMemsetAsync((char*)d_ws + WS_CTL, 0, CTL_ZERO_BYTES, stream) != hipSuccess) { fprintf(stderr, "kernel_launch: memset failed\n"); return; }
    Args a{};
    for (int i = 0; i < 18; ++i) a.in[i] = (const float*)d_in[i];
    a.out = (float*)d_out; a.ws = (unsigned char*)d_ws;
    void* kargs[] = {&a};
    const hipError_t e = hipLaunchCooperativeKernel((const void*)mega_fwd, dim3(grid), dim3(NWAVES * 64), kargs, LDS_BYTES, stream);
    if (e != hipSuccess) fprintf(stderr, "kernel_launch: cooperative launch failed: %s (grid %d)\n", hipGetErrorString(e), grid);
}
```

```cpp
#include <hip/hip_runtime.h>
#include <hip/hip_cooperative_groups.h>
#include <cstdio>
#include <cstdint>
namespace cg = cooperative_groups;
namespace pg8 {
#define PG8_LAS __attribute__((address_space(3)))
typedef unsigned short bf16_t;
typedef short bf16x8 __attribute__((ext_vector_type(8)));
typedef float f32x4 __attribute__((ext_vector_type(4)));
typedef unsigned u32x4 __attribute__((ext_vector_type(4)));
constexpr int BM = 256, BK = 64, HALF = 128, HTB = HALF * BK * 2  , STAGE_BYTES = 8 * HTB, NXCD = 8, WGM = 8;

__host__ __device__ __forceinline__ int lds_byte(int r, int c) { const int st = (r >> 4) * 2 + (c >> 5), rr = r & 15, cc = c & 31, ob = rr * 64 + cc * 2; return st * 1024 + (ob ^ (((ob >> 9) & 1) << 5)); }
__host__ __device__ __forceinline__ void stage_rc(int b, int& R, int& C) { const int st = b / 1024, sb = b % 1024, swz = sb ^ (((sb >> 9) & 1) << 5); R = (st >> 1) * 16 + swz / 64; C = (st & 1) * 32 + (swz % 64) / 2; }
__host__ __device__ __forceinline__ int perm32(int rho) { const int n = rho >> 4, i = rho & 15; return 8 * (i >> 2) + 4 * n + (i & 3); }

struct Unit { int pm, pn; };
struct Gemm { const bf16_t* A; const bf16_t* Bt; int M, N, K; };

struct StaticOrder {
    int nM, nN, nwg, G, c;
    __host__ __device__ void init(int M, int N, int G_, int c_) { nM = M / BM; nN = N / BM; nwg = nM * nN; G = G_; c = c_; }
    __host__ __device__ bool next(int i, Unit& u) const {
        const long L = (long)i * G + c; if (L >= nwg) return false;
        int wgid = (int)L; { const int q = nwg / NXCD, r = nwg % NXCD, xcd = wgid % NXCD, off = wgid / NXCD; wgid = (xcd < r ? xcd * (q + 1) : r * (q + 1) + (xcd - r) * q) + off; }
        const int nig = WGM * nN, gid = wgid / nig, fm = gid * WGM, gsz = (nM - fm) < WGM ? (nM - fm) : WGM;
        u.pm = fm + ((wgid % nig) % gsz); u.pn = (wgid % nig) / gsz; return true;
    }
    __device__ __forceinline__ void a_ready(const Unit&) const {}
    __device__ __forceinline__ void done(const Unit&) const {}
};


typedef unsigned u32x2 __attribute__((ext_vector_type(2)));
__device__ __forceinline__ unsigned cvt_pk_bf16(float lo, float hi) { unsigned r; asm volatile("v_cvt_pk_bf16_f32 %0, %1, %2" : "=v"(r) : "v"(lo), "v"(hi)); return r; }
constexpr float RMS_EPS = 1e-6f, LOG2E = 1.4426950408889634f;
__device__ __forceinline__ float row_rinv(const float* ssq, int row) { const f32x4 s = *(const f32x4*)(ssq + (size_t)row * 4); return rsqrtf(((s[0] + s[1]) + (s[2] + s[3])) * (1.0f / 1024.0f) + RMS_EPS); }
__device__ __forceinline__ float sigmoid_f(float a) { return __builtin_amdgcn_rcpf(1.0f + __builtin_amdgcn_exp2f(-a * LOG2E)); }

struct EpiQKV0 {
    static constexpr bool PERM = true, AFTER_DRAIN = false;
    bf16_t* O; size_t tstride; const float* ssq; float qscale;
    __device__ __forceinline__ void operator()(const f32x4 (&acc)[2][2][4][2], const Unit& u, int wr, int wc, int fr, int fq) const {
        const int row0 = u.pm * BM + wr * 64 + fr; const int t = u.pn >> 2; bf16_t* base = O + (size_t)t * tstride;
        const float sc = (t == 0) ? qscale : 1.f; const int col0 = (u.pn & 3) * 256 + wc * 32 + 8 * fq;
        float ri[2][4];
#pragma unroll
        for (int ai = 0; ai < 2; ++ai)
#pragma unroll
            for (int m = 0; m < 4; ++m) ri[ai][m] = row_rinv(ssq, row0 + ai * HALF + m * 16) * sc;
#pragma unroll
        for (int ai = 0; ai < 2; ++ai)
#pragma unroll
            for (int m = 0; m < 4; ++m) { const int row = row0 + ai * HALF + m * 16; const float r = ri[ai][m]; bf16_t* rowp = base + (size_t)row * 1024 + col0;
#pragma unroll
                for (int bj = 0; bj < 2; ++bj) { const f32x4 v0 = acc[ai][bj][m][0] * r, v1 = acc[ai][bj][m][1] * r;
                    u32x4 w; w.x = cvt_pk_bf16(v0[0], v0[1]); w.y = cvt_pk_bf16(v0[2], v0[3]); w.z = cvt_pk_bf16(v1[0], v1[1]); w.w = cvt_pk_bf16(v1[2], v1[3]);
                    *(u32x4*)(rowp + bj * HALF) = w; } }
    }
};
struct EpiKVQ1 {
    static constexpr bool PERM = true, AFTER_DRAIN = false;
    bf16_t* O; size_t tstride; const float* ssq; const float* gk; const float* gq; float qscale;
    __device__ __forceinline__ void operator()(const f32x4 (&acc)[2][2][4][2], const Unit& u, int wr, int wc, int fr, int fq) const {
        const int row0 = u.pm * BM + wr * 64 + fr; const int t = u.pn >> 2; bf16_t* base = O + (size_t)((t + 1) % 3) * tstride;
        const int head = (u.pn & 3) * 4 + wc;
        f32x4 gv[2][2];
        if (t != 1) { const float* g = (t == 0) ? gk : gq; const float s = (t == 0) ? 1.f : qscale;
#pragma unroll
            for (int bj = 0; bj < 2; ++bj)
#pragma unroll
                for (int n = 0; n < 2; ++n) gv[bj][n] = *(const f32x4*)(g + 32 * bj + 8 * fq + 4 * n) * s; }
        float ri[2][4];
#pragma unroll
        for (int ai = 0; ai < 2; ++ai)
#pragma unroll
            for (int m = 0; m < 4; ++m) ri[ai][m] = row_rinv(ssq, row0 + ai * HALF + m * 16);
#pragma unroll
        for (int ai = 0; ai < 2; ++ai)
#pragma unroll
            for (int m = 0; m < 4; ++m) { const int row = row0 + ai * HALF + m * 16; const float r = ri[ai][m];
                f32x4 v[2][2];
#pragma unroll
                for (int bj = 0; bj < 2; ++bj)
#pragma unroll
                    for (int n = 0; n < 2; ++n) v[bj][n] = acc[ai][bj][m][n] * r;
                if (t != 1) { float ss = 0.f;
#pragma unroll
                    for (int bj = 0; bj < 2; ++bj)
#pragma unroll
                        for (int n = 0; n < 2; ++n) { const f32x4 x = v[bj][n]; ss += (x[0] * x[0] + x[1] * x[1]) + (x[2] * x[2] + x[3] * x[3]); }
                    ss += __shfl_xor(ss, 16); ss += __shfl_xor(ss, 32);
                    const float rn = rsqrtf(ss * (1.0f / 64.0f) + RMS_EPS);
#pragma unroll
                    for (int bj = 0; bj < 2; ++bj)
#pragma unroll
                        for (int n = 0; n < 2; ++n) v[bj][n] = v[bj][n] * rn * gv[bj][n]; }
                bf16_t* rowp = base + (size_t)row * 1024 + head * 64 + 8 * fq;
#pragma unroll
                for (int bj = 0; bj < 2; ++bj) { const f32x4 v0 = v[bj][0], v1 = v[bj][1];
                    u32x4 w; w.x = cvt_pk_bf16(v0[0], v0[1]); w.y = cvt_pk_bf16(v0[2], v0[3]); w.z = cvt_pk_bf16(v1[0], v1[1]); w.w = cvt_pk_bf16(v1[2], v1[3]);
                    *(u32x4*)(rowp + 32 * bj) = w; } }
    }
};
struct EpiGU {
    static constexpr bool PERM = true, AFTER_DRAIN = false;
    bf16_t* O; const float* ssq;
    __device__ __forceinline__ void operator()(const f32x4 (&acc)[2][2][4][2], const Unit& u, int wr, int wc, int fr, int fq) const {
        const int row0 = u.pm * BM + wr * 64 + fr; const int col0 = u.pn * 128 + wc * 32 + 8 * fq;
        float ri[2][4];
#pragma unroll
        for (int ai = 0; ai < 2; ++ai)
#pragma unroll
            for (int m = 0; m < 4; ++m) ri[ai][m] = row_rinv(ssq, row0 + ai * HALF + m * 16);
#pragma unroll
        for (int ai = 0; ai < 2; ++ai)
#pragma unroll
            for (int m = 0; m < 4; ++m) { const int row = row0 + ai * HALF + m * 16; const float r = ri[ai][m]; bf16_t* rowp = O + (size_t)row * 2816 + col0;
                f32x4 a[2]; const float c1 = -r * LOG2E, r2 = r * r;
#pragma unroll
                for (int n = 0; n < 2; ++n) { const f32x4 ag = acc[ai][0][m][n], au = acc[ai][1][m][n]; f32x4 ea = ag * c1; const f32x4 pr = (ag * au) * r2;
#pragma unroll
                    for (int i = 0; i < 4; ++i) ea[i] = __builtin_amdgcn_rcpf(1.0f + __builtin_amdgcn_exp2f(ea[i]));
                    a[n] = pr * ea; }
                u32x4 w; w.x = cvt_pk_bf16(a[0][0], a[0][1]); w.y = cvt_pk_bf16(a[0][2], a[0][3]); w.z = cvt_pk_bf16(a[1][0], a[1][1]); w.w = cvt_pk_bf16(a[1][2], a[1][3]);
                *(u32x4*)rowp = w; }
    }
};
__device__ __forceinline__ void bf8_to_f32(u32x4 pw, f32x4& lo, f32x4& hi_) {
    lo[0] = __uint_as_float(pw.x << 16); lo[1] = __uint_as_float(pw.x & 0xffff0000u); lo[2] = __uint_as_float(pw.y << 16); lo[3] = __uint_as_float(pw.y & 0xffff0000u);
    hi_[0] = __uint_as_float(pw.z << 16); hi_[1] = __uint_as_float(pw.z & 0xffff0000u); hi_[2] = __uint_as_float(pw.w << 16); hi_[3] = __uint_as_float(pw.w & 0xffff0000u); }
__device__ __forceinline__ u32x4 f32_to_bf8(const f32x4& v0, const f32x4& v1) { u32x4 w; w.x = cvt_pk_bf16(v0[0], v0[1]); w.y = cvt_pk_bf16(v0[2], v0[3]); w.z = cvt_pk_bf16(v1[0], v1[1]); w.w = cvt_pk_bf16(v1[2], v1[3]); return w; }
__device__ __forceinline__ float sumsq4(const f32x4& v) { return (v[0] * v[0] + v[1] * v[1]) + (v[2] * v[2] + v[3] * v[3]); }
struct EpiProj {
    static constexpr bool PERM = true, AFTER_DRAIN = false;
    bf16_t* O;
    __device__ __forceinline__ void operator()(const f32x4 (&acc)[2][2][4][2], const Unit& u, int wr, int wc, int fr, int fq) const {
        const int row0 = u.pm * BM + wr * 64 + fr; const int col0 = u.pn * BM + wc * 32 + 8 * fq;
#pragma unroll
        for (int ai = 0; ai < 2; ++ai)
#pragma unroll
            for (int m = 0; m < 4; ++m) { bf16_t* rowp = O + (size_t)(row0 + ai * HALF + m * 16) * 1024 + col0;
#pragma unroll
                for (int bj = 0; bj < 2; ++bj) *(u32x4*)(rowp + bj * HALF) = f32_to_bf8(acc[ai][bj][m][0], acc[ai][bj][m][1]); }
    }
};
template <bool BASE_F32> struct EpiRes {
    static constexpr bool PERM = true, AFTER_DRAIN = true;
    const void* base; bf16_t* hb; float* ssq_out;
    __device__ __forceinline__ void fused(const f32x4 (&acc)[2][2][4][2], const Unit& u, int wr, int wc, int fr, int fq, PG8_LAS unsigned char* lds, int wid, int lane) const {
        PG8_LAS float* P = (PG8_LAS float*)lds;
        const int col0 = u.pn * BM + wc * 32 + 8 * fq;
#pragma unroll
        for (int ai = 0; ai < 2; ++ai) {
            f32x4 b0[4][2], b1[4][2];
#pragma unroll
            for (int m = 0; m < 4; ++m) { const size_t off = (size_t)(u.pm * BM + ai * HALF + wr * 64 + m * 16 + fr) * 1024 + col0;
#pragma unroll
                for (int bj = 0; bj < 2; ++bj) { const size_t o2 = off + bj * HALF;
                    if (BASE_F32) { b0[m][bj] = *(const f32x4*)((const float*)base + o2); b1[m][bj] = *(const f32x4*)((const float*)base + o2 + 4); }
                    else bf8_to_f32(*(const u32x4*)((const bf16_t*)base + o2), b0[m][bj], b1[m][bj]); } }
#pragma unroll
            for (int m = 0; m < 4; ++m) { const int r = ai * HALF + wr * 64 + m * 16 + fr; const size_t off = (size_t)(u.pm * BM + r) * 1024 + col0; float s = 0.f;
#pragma unroll
                for (int bj = 0; bj < 2; ++bj) { const f32x4 v0 = b0[m][bj] + acc[ai][bj][m][0], v1 = b1[m][bj] + acc[ai][bj][m][1];
                    *(u32x4*)(hb + off + bj * HALF) = f32_to_bf8(v0, v1); s += sumsq4(v0) + sumsq4(v1); }
                s += __shfl_xor(s, 16); s += __shfl_xor(s, 32);
                if (fq == 0) P[r * 4 + wc] = s; } }
        asm volatile("s_waitcnt lgkmcnt(0)" ::: "memory"); __builtin_amdgcn_s_barrier(); asm volatile("" ::: "memory");
        const int tid = wid * 64 + lane;
        if (tid < 256) { const f32x4 p = *(const PG8_LAS f32x4*)(P + tid * 4); ssq_out[(size_t)(u.pm * BM + tid) * 4 + u.pn] = (p[0] + p[1]) + (p[2] + p[3]); }
        asm volatile("s_waitcnt lgkmcnt(0)" ::: "memory"); __builtin_amdgcn_s_barrier(); asm volatile("" ::: "memory");
    }
};
struct EpiPle {
    static constexpr bool PERM = true, AFTER_DRAIN = true;
    const float* ssq_in; const bf16_t* hin; const bf16_t* projp; bf16_t* hb_out; float* fout; float* ssq_out;
    __device__ __forceinline__ void fused(const f32x4 (&acc)[2][2][4][2], const Unit& u, int wr, int wc, int fr, int fq, PG8_LAS unsigned char* lds, int wid, int lane) const {
        PG8_LAS float* P = (PG8_LAS float*)lds;
        const int col0 = u.pn * BM + wc * 32 + 8 * fq;
        float riv[2][4];
#pragma unroll
        for (int ai = 0; ai < 2; ++ai)
#pragma unroll
            for (int m = 0; m < 4; ++m) riv[ai][m] = row_rinv(ssq_in, u.pm * BM + ai * HALF + wr * 64 + m * 16 + fr);
#pragma unroll
        for (int ai = 0; ai < 2; ++ai) {
            u32x4 hv[4][2], pv[4][2];
#pragma unroll
            for (int m = 0; m < 4; ++m) { const size_t off = (size_t)(u.pm * BM + ai * HALF + wr * 64 + m * 16 + fr) * 1024 + col0;
#pragma unroll
                for (int bj = 0; bj < 2; ++bj) { hv[m][bj] = *(const u32x4*)(hin + off + bj * HALF); pv[m][bj] = *(const u32x4*)(projp + off + bj * HALF); } }
#pragma unroll
            for (int m = 0; m < 4; ++m) { const int r = ai * HALF + wr * 64 + m * 16 + fr; const size_t off = (size_t)(u.pm * BM + r) * 1024 + col0; float s = 0.f;
                const float ri = riv[ai][m];
#pragma unroll
                for (int bj = 0; bj < 2; ++bj) { const size_t o2 = off + bj * HALF; f32x4 h0, h1, p0, p1; bf8_to_f32(hv[m][bj], h0, h1); bf8_to_f32(pv[m][bj], p0, p1);
                    const f32x4 a0 = acc[ai][bj][m][0] * ri, a1 = acc[ai][bj][m][1] * ri; f32x4 v0, v1;
#pragma unroll
                    for (int i = 0; i < 4; ++i) { v0[i] = h0[i] + sigmoid_f(a0[i]) * p0[i]; v1[i] = h1[i] + sigmoid_f(a1[i]) * p1[i]; }
                    if (fout) { *(f32x4*)(fout + o2) = v0; *(f32x4*)(fout + o2 + 4) = v1; }
                    if (hb_out) *(u32x4*)(hb_out + o2) = f32_to_bf8(v0, v1);
                    s += sumsq4(v0) + sumsq4(v1); }
                s += __shfl_xor(s, 16); s += __shfl_xor(s, 32);
                if (fq == 0) P[r * 4 + wc] = s; } }
        asm volatile("s_waitcnt lgkmcnt(0)" ::: "memory"); __builtin_amdgcn_s_barrier(); asm volatile("" ::: "memory");
        const int tid = wid * 64 + lane;
        if (ssq_out && tid < 256) { const f32x4 p = *(const PG8_LAS f32x4*)(P + tid * 4); ssq_out[(size_t)(u.pm * BM + tid) * 4 + u.pn] = (p[0] + p[1]) + (p[2] + p[3]); }
        asm volatile("s_waitcnt lgkmcnt(0)" ::: "memory"); __builtin_amdgcn_s_barrier(); asm volatile("" ::: "memory");
    }
};
struct OneUnit {
    Unit u;
    __device__ __forceinline__ bool next(int i, Unit& o) const { if (i) return false; o = u; return true; }
    __device__ __forceinline__ void a_ready(const Unit&) const {}
    __device__ __forceinline__ void done(const Unit&) const {}
};

template <class Epi, class Sched, bool ALIGN_EPI = false, bool SP2 = false>
__device__ __forceinline__ void gemm_phase(PG8_LAS unsigned char* lds, const Gemm g, const Sched& S, const Epi& E) {
    int tid_ = threadIdx.x; asm volatile("" : "+v"(tid_));
    const int tid = tid_, wid = __builtin_amdgcn_readfirstlane(tid >> 6), lane = tid & 63, wr = wid >> 2, wc = wid & 3, fr = lane & 15, fq = lane >> 4;
    const int K = g.K, nt = K / BK;
    unsigned voffA[2], voffB[2];
#pragma unroll
    for (int i = 0; i < 2; ++i) { int R, C; stage_rc(tid * 16 + i * 8192, R, C); const int Rb = Epi::PERM ? ((R & ~31) + perm32(R & 31)) : R;
        voffA[i] = (unsigned)(R * K + C) * 2u; voffB[i] = (unsigned)(Rb * K + C) * 2u; }
    const size_t kstep = (size_t)(BK * 2);
    const size_t hstep = (size_t)HALF * K * 2;
    const size_t tstep = 2 * hstep;
    const unsigned ldsw = (unsigned)wid * 1024u;
    const int aoff = lds_byte(wr * 64 + fr, fq * 8), boff = lds_byte(wc * 32 + fr, fq * 8);
#define PG8_SA(b, h) (((b) * 2 + (h)) * HTB)
#define PG8_SB(b, h) ((4 + (b) * 2 + (h)) * HTB)
#define PG8_STAGE(bufoff, gbase, voff) do { _Pragma("unroll") for (int _i = 0; _i < 2; ++_i) \
        __builtin_amdgcn_global_load_lds((const unsigned*)((const char*)(gbase) + (voff)[_i]), (PG8_LAS unsigned*)(lds + (bufoff) + ldsw + _i * 8192), 16, 0, 0); } while (0)
#define PG8_LDA(dst, b, h) do { _Pragma("unroll") for (int m = 0; m < 4; ++m) _Pragma("unroll") for (int k = 0; k < 2; ++k) dst[m][k] = *(const PG8_LAS bf16x8*)(lds + PG8_SA(b, h) + aoff + m * 2048 + k * 1024); } while (0)
#define PG8_LDB(dst, b, h) do { _Pragma("unroll") for (int n = 0; n < 2; ++n) _Pragma("unroll") for (int k = 0; k < 2; ++k) dst[n][k] = *(const PG8_LAS bf16x8*)(lds + PG8_SB(b, h) + boff + n * 2048 + k * 1024); } while (0)
#define PG8_MMA(ai, bj, At, Bt) do { __builtin_amdgcn_s_setprio(1); _Pragma("unroll") for (int m = 0; m < 4; ++m) _Pragma("unroll") for (int n = 0; n < 2; ++n) _Pragma("unroll") for (int k = 0; k < 2; ++k) \
        acc[ai][bj][m][n] = __builtin_amdgcn_mfma_f32_16x16x32_bf16(Bt[n][k], At[m][k], acc[ai][bj][m][n], 0, 0, 0); __builtin_amdgcn_s_setprio(0); } while (0)
#define PG8_WAIT_V(n) asm volatile("s_waitcnt vmcnt(" #n ")" ::: "memory")
#define PG8_WAIT_L(n) asm volatile("s_waitcnt lgkmcnt(" #n ")" ::: "memory")
#define PG8_BAR __builtin_amdgcn_s_barrier()
#define PG8_SCHED __builtin_amdgcn_sched_barrier(0)
    Unit cur, nxt; int ui = 0;
    if (!S.next(0, cur)) return;
    f32x4 acc[2][2][4][2];
#pragma unroll
    for (int a = 0; a < 2; ++a)
#pragma unroll
        for (int b = 0; b < 2; ++b)
#pragma unroll
            for (int m = 0; m < 4; ++m)
#pragma unroll
                for (int n = 0; n < 2; ++n) acc[a][b][m][n] = (f32x4){0.f, 0.f, 0.f, 0.f};
    bf16x8 At[4][2], B0[2][2], B1[2][2];
    const char* cA = (const char*)g.A + (size_t)cur.pm * tstep; const char* cB = (const char*)g.Bt + (size_t)cur.pn * tstep;
    S.a_ready(cur);
    if constexpr (SP2) {
        PG8_STAGE(PG8_SB(0, 0), cB, voffB); PG8_STAGE(PG8_SB(0, 1), cB + hstep, voffB); PG8_STAGE(PG8_SA(0, 0), cA, voffA); PG8_STAGE(PG8_SA(0, 1), cA + hstep, voffA);
        if (wr == 1) PG8_BAR;
        PG8_WAIT_V(2); PG8_BAR;
        PG8_STAGE(PG8_SB(1, 0), cB + kstep, voffB); PG8_STAGE(PG8_SA(1, 0), cA + kstep, voffA); PG8_STAGE(PG8_SB(1, 1), cB + hstep + kstep, voffB);
        PG8_WAIT_V(6); PG8_BAR;
    } else {
        PG8_STAGE(PG8_SB(0, 0), cB, voffB); PG8_STAGE(PG8_SA(0, 0), cA, voffA); PG8_STAGE(PG8_SB(0, 1), cB + hstep, voffB); PG8_STAGE(PG8_SA(0, 1), cA + hstep, voffA);
        if (wr == 1) PG8_BAR;
        PG8_WAIT_V(4); PG8_BAR;
        PG8_STAGE(PG8_SB(1, 0), cB + kstep, voffB); PG8_STAGE(PG8_SA(1, 0), cA + kstep, voffA); PG8_STAGE(PG8_SB(1, 1), cB + hstep + kstep, voffB);
        PG8_WAIT_V(6); PG8_BAR;
    }
    for (;;) {
        const bool has_next = S.next(ui + 1, nxt);
        const char* nA = has_next ? (const char*)g.A + (size_t)nxt.pm * tstep : cA; const char* nB = has_next ? (const char*)g.Bt + (size_t)nxt.pn * tstep : cB;
        for (int t = 0; t < nt; t += 2) {
            const bool last = (t == nt - 2);
            const char* a1 = cA + (size_t)(t + 1) * kstep;
            const char* a2 = last ? nA : cA + (size_t)(t + 2) * kstep; const char* b2 = last ? nB : cB + (size_t)(t + 2) * kstep;
            const char* a3 = a2 + kstep; const char* b3 = b2 + kstep;
            if (last && has_next) S.a_ready(nxt);
            if constexpr (SP2) {
            PG8_LDB(B0, 0, 0); PG8_LDB(B1, 0, 1); PG8_SCHED; PG8_LDA(At, 0, 0); PG8_STAGE(PG8_SA(1, 1), a1 + hstep, voffA);
            PG8_WAIT_V(8); PG8_WAIT_L(0); PG8_BAR; PG8_MMA(0, 0, At, B0); PG8_MMA(0, 1, At, B1); PG8_BAR; PG8_SCHED;
            PG8_LDA(At, 0, 1); PG8_STAGE(PG8_SB(0, 0), b2, voffB); PG8_STAGE(PG8_SB(0, 1), b2 + hstep, voffB); PG8_STAGE(PG8_SA(0, 0), a2, voffA);
            PG8_WAIT_V(8); PG8_WAIT_L(0); PG8_BAR; PG8_MMA(1, 0, At, B0); PG8_MMA(1, 1, At, B1); PG8_BAR; PG8_SCHED;
            PG8_LDB(B0, 1, 0); PG8_LDB(B1, 1, 1); PG8_SCHED; PG8_LDA(At, 1, 0); PG8_STAGE(PG8_SA(0, 1), a2 + hstep, voffA);
            PG8_WAIT_V(8); PG8_WAIT_L(0); PG8_BAR; PG8_MMA(0, 0, At, B0); PG8_MMA(0, 1, At, B1); PG8_BAR; PG8_SCHED;
            PG8_LDA(At, 1, 1); PG8_STAGE(PG8_SB(1, 0), b3, voffB); PG8_STAGE(PG8_SB(1, 1), b3 + hstep, voffB); PG8_STAGE(PG8_SA(1, 0), a3, voffA);
            PG8_WAIT_V(8); PG8_WAIT_L(0); PG8_BAR; PG8_MMA(1, 0, At, B0); PG8_MMA(1, 1, At, B1); PG8_BAR; PG8_SCHED;
            } else {
            PG8_LDB(B0, 0, 0); PG8_SCHED; PG8_LDA(At, 0, 0); PG8_STAGE(PG8_SA(1, 1), a1 + hstep, voffA);
            PG8_WAIT_L(8); PG8_BAR; PG8_WAIT_L(0); PG8_MMA(0, 0, At, B0); PG8_BAR; PG8_SCHED;
            PG8_LDB(B1, 0, 1); PG8_STAGE(PG8_SB(0, 0), b2, voffB);
            PG8_BAR; PG8_WAIT_L(0); PG8_MMA(0, 1, At, B1); PG8_BAR;
            PG8_LDA(At, 0, 1); PG8_STAGE(PG8_SA(0, 0), a2, voffA);
            PG8_BAR; PG8_WAIT_L(0); PG8_MMA(1, 0, At, B0); PG8_BAR; PG8_SCHED;
            PG8_STAGE(PG8_SB(0, 1), b2 + hstep, voffB);
            PG8_WAIT_V(6); PG8_BAR; PG8_MMA(1, 1, At, B1); PG8_BAR;
            PG8_LDB(B0, 1, 0); PG8_SCHED; PG8_LDA(At, 1, 0); PG8_STAGE(PG8_SA(0, 1), a2 + hstep, voffA);
            PG8_WAIT_L(8); PG8_BAR; PG8_WAIT_L(0); PG8_MMA(0, 0, At, B0); PG8_BAR; PG8_SCHED;
            PG8_LDB(B1, 1, 1); PG8_STAGE(PG8_SB(1, 0), b3, voffB);
            PG8_BAR; PG8_WAIT_L(0); PG8_MMA(0, 1, At, B1); PG8_BAR;
            PG8_LDA(At, 1, 1); PG8_STAGE(PG8_SA(1, 0), a3, voffA);
            PG8_BAR; PG8_WAIT_L(0); PG8_MMA(1, 0, At, B0); PG8_BAR; PG8_SCHED;
            PG8_STAGE(PG8_SB(1, 1), b3 + hstep, voffB);
            PG8_WAIT_V(6); PG8_BAR; PG8_MMA(1, 1, At, B1); PG8_BAR;
            }
        }
        if constexpr (ALIGN_EPI) { if (wr == 0) PG8_BAR; }
        if constexpr (!Epi::AFTER_DRAIN) { E(acc, cur, wr, wc, fr, fq); S.done(cur); }
        if (!has_next) break;
#pragma unroll
        for (int a = 0; a < 2; ++a)
#pragma unroll
            for (int b = 0; b < 2; ++b)
#pragma unroll
                for (int m = 0; m < 4; ++m)
#pragma unroll
                    for (int n = 0; n < 2; ++n) acc[a][b][m][n] = (f32x4){0.f, 0.f, 0.f, 0.f};
        cur = nxt; cA = nA; cB = nB; ++ui;
        if constexpr (ALIGN_EPI) { if (wr == 1) PG8_BAR; }
    }
    PG8_WAIT_V(0);
    if constexpr (!ALIGN_EPI) { if (wr == 0) PG8_BAR; }
    PG8_BAR;
    if constexpr (Epi::AFTER_DRAIN) { E.fused(acc, cur, wr, wc, fr, fq, lds, wid, lane); S.done(cur); }
#undef PG8_SA
#undef PG8_SB
#undef PG8_STAGE
#undef PG8_LDA
#undef PG8_LDB
#undef PG8_MMA
#undef PG8_WAIT_V
#undef PG8_WAIT_L
#undef PG8_BAR
#undef PG8_SCHED
}
}

constexpr int M = 16384, D = 1024, NH = 16, DH = 64, FF = 2816, PLE = 256;
constexpr float LOG2E_F = 1.4426950408889634f;
constexpr float QSCALE = 0.125f * LOG2E_F;
constexpr float THR2 = 120.0f;
constexpr float SB_EPS = 7.5e-37f;
constexpr int NWAVES = 8;

#define GAS __attribute__((address_space(1)))
#define LAS __attribute__((address_space(3)))
typedef unsigned short bf16;
typedef unsigned v4u __attribute__((ext_vector_type(4)));
typedef unsigned v2u __attribute__((ext_vector_type(2)));
typedef float f32x4 __attribute__((ext_vector_type(4)));
typedef float f32x16 __attribute__((ext_vector_type(16)));
typedef short bf16x8 __attribute__((ext_vector_type(8)));
typedef short s16x4 __attribute__((ext_vector_type(4)));
#define RLX_AGENT __ATOMIC_RELAXED, __HIP_MEMORY_SCOPE_AGENT
#define LDS_WAIT() asm volatile("s_waitcnt lgkmcnt(0)" ::: "memory")
__device__ __forceinline__ unsigned f2bf(float f) { unsigned u = __builtin_bit_cast(unsigned, f); return (u + 0x7fffu + ((u >> 16) & 1u)) >> 16; }
__device__ __forceinline__ unsigned pk2(float lo, float hi) { return f2bf(lo) | (f2bf(hi) << 16); }
__device__ __forceinline__ unsigned cvtpk(float lo, float hi) { unsigned r; asm volatile("v_cvt_pk_bf16_f32 %0, %1, %2" : "=v"(r) : "v"(lo), "v"(hi)); return r; }
__device__ __forceinline__ float ex2(float x) { return __builtin_amdgcn_exp2f(x); }
__device__ __forceinline__ float lg2(float x) { return __builtin_amdgcn_logf(x); }

constexpr size_t MiB = 1u << 20;
constexpr size_t WS_CTL = 0, CTL_ZERO_BYTES = 64 * 1024;
constexpr size_t WS_SSQ = 1 * MiB;
constexpr size_t WS_WF = 1 * MiB + 6 * 256 * 1024;
constexpr size_t WS_LS2 = 3 * MiB;
constexpr size_t WS_TT = 128 * 1024;
constexpr size_t WS_WQKV0 = 4 * MiB, WS_WO0 = 10 * MiB, WS_WKVQ1 = 12 * MiB, WS_WO1 = 18 * MiB, WS_WGU = 20 * MiB  , WS_WD = 42 * MiB  , WS_WG = 53 * MiB  , WS_WP = 57 * MiB  ;
constexpr size_t WS_HBA = 58 * MiB, WS_HBB = 90 * MiB, WS_Q = 122 * MiB, WS_K = 154 * MiB, WS_V = 186 * MiB, WS_ACT = 122 * MiB  , WS_PBUF0 = WS_HBB  , WS_PBUF1 = WS_WQKV0  , WS_PROJ = 218 * MiB, WS_END = 250 * MiB;
constexpr int CW_BAR = 1024;

constexpr int RING_BYTES = 131072, LDS_BYTES = 163840, MISC_OFF = LDS_BYTES - 256;

#define XB_TMO      128
#define XB_XCNT(j)  (256  + 64 * (j))
#define XB_XSUB(j)  (1280 + 64 * (j))
#define XB_XGEN(j)  (2304 + 64 * (j))
#define XB_TOP      3328
#define XB_TOPGEN   3392
#define XCD_BAR_WORDS 3456
#define XB_SPIN_CAP (1u << 18)

__device__ __forceinline__ unsigned xb_ld(unsigned* p)              { return __hip_atomic_load(p, __ATOMIC_RELAXED, __HIP_MEMORY_SCOPE_AGENT); }
__device__ __forceinline__ unsigned xb_add(unsigned* p, unsigned v) { return __hip_atomic_fetch_add(p, v, __ATOMIC_RELAXED, __HIP_MEMORY_SCOPE_AGENT); }
__device__ __forceinline__ unsigned xb_xcc_id() { return (unsigned)__builtin_amdgcn_s_getreg((3 << 11) | 20) & 0xFu; }
#define XB_SPIN(cond, bar) do { unsigned _sp = 0; while (cond) { __builtin_amdgcn_s_sleep(1); \
    if ((++_sp & 255u) == 0u) { if (xb_ld(&(bar)[XB_TMO])) break; if (_sp > XB_SPIN_CAP) { atomicAdd(&(bar)[XB_TMO], 1u); break; } } } } while (0)

struct XcdBarrier {
    unsigned* bar; unsigned x;
    volatile LAS unsigned* st;
};

__device__ __forceinline__ XcdBarrier xcd_barrier_post(unsigned* bar, volatile LAS unsigned* st) {
    XcdBarrier b; b.bar = bar; b.x = xb_xcc_id(); b.st = st;
    if (threadIdx.x == 0) (void)xb_add(&bar[XB_XCNT(b.x)], 1u);
    return b;
}
__device__ __forceinline__ void xcd_barrier_complete(unsigned* bar, unsigned x, unsigned& nloc, unsigned& nx) {
    const unsigned G = gridDim.x * gridDim.y * gridDim.z;
    unsigned sum, cnt, mine, sp = 0u;
    for (;;) {
        sum = 0u; cnt = 0u; mine = 0u;
#pragma unroll
        for (unsigned j = 0; j < 16; ++j) { const unsigned c = xb_ld(&bar[XB_XCNT(j)]); sum += c; cnt += (c > 0u) ? 1u : 0u; mine = (j == x) ? c : mine; }
        if (sum == G) break;
        __builtin_amdgcn_s_sleep(1);
        if ((++sp & 255u) == 0u) { if (xb_ld(&bar[XB_TMO])) break; if (sp > XB_SPIN_CAP) { atomicAdd(&bar[XB_TMO], 1u); break; } }
    }
    nloc = mine > 0u ? mine : 1u; nx = cnt > 0u ? cnt : 1u;
}

__device__ __forceinline__ void xcd_barrier(const XcdBarrier& b) {
    asm volatile("s_waitcnt vmcnt(0)" ::: "memory");
    __syncthreads();
    if (threadIdx.x == 0) {
        unsigned* bar = b.bar;
        __builtin_amdgcn_s_waitcnt(0);
        unsigned nloc = b.st[0], nx = b.st[1];
        if (nloc == 0u) { xcd_barrier_complete(bar, b.x, nloc, nx); b.st[0] = nloc; b.st[1] = nx; }
        const unsigned old = xb_add(&bar[XB_XSUB(b.x)], 1u);
        const unsigned gen = old / nloc;
        if (old + 1u == (gen + 1u) * nloc) {
            __builtin_amdgcn_fence(__ATOMIC_RELEASE, "agent");
            asm volatile("s_waitcnt vmcnt(0)" ::: "memory");
            const unsigned og = xb_add(&bar[XB_TOP], 1u);
            const unsigned tg = og / nx;
            if (og + 1u == (tg + 1u) * nx) xb_add(&bar[XB_TOPGEN], 1u);
            else XB_SPIN(xb_ld(&bar[XB_TOPGEN]) == tg, bar);
            __builtin_amdgcn_fence(__ATOMIC_ACQUIRE, "agent");
            xb_add(&bar[XB_XGEN(b.x)], 1u);
            asm volatile("s_waitcnt vmcnt(0)" ::: "memory");
        } else {
            XB_SPIN(xb_ld(&bar[XB_XGEN(b.x)]) == gen, bar);
            __builtin_amdgcn_fence(__ATOMIC_ACQUIRE, "agent");
            asm volatile("s_waitcnt vmcnt(0)" ::: "memory");
        }
    }
    __syncthreads();
}

struct TrDesc { const float* W; const float* gain; bf16* WT; int K, ldw, csrc0, nblk, map, item; };
__device__ __forceinline__ void tr_issue(const TrDesc& d, int lane, float (&w)[64]) {
    const int kb = d.item / d.nblk, nb = d.item % d.nblk, k0 = 64 * kb, n = 64 * nb + lane;
    const float* src = d.W + (size_t)k0 * d.ldw + d.csrc0 + n;
#pragma unroll
    for (int i = 0; i < 64; ++i) w[i] = src[(size_t)i * d.ldw];
}
__device__ __forceinline__ void tr_finish(const TrDesc& d, int lane, float (&w)[64]) {
    const int kb = d.item / d.nblk, nb = d.item % d.nblk, k0 = 64 * kb, n = 64 * nb + lane;
    int v = n;
    if (d.map == 1) { const int head = n >> 6, c = n & 63; v = 256 * (head >> 2) + 128 * (c >> 5) + 32 * (head & 3) + (c & 31); }
    else if (d.map == 2) { const int isu = n >= FF, c = isu ? n - FF : n; v = 256 * (c >> 7) + 128 * isu + (c & 127); }
    if (d.gain) {
#pragma unroll
        for (int i = 0; i < 64; ++i) w[i] *= d.gain[k0 + i]; }
    v4u* dst = (v4u*)(d.WT + (size_t)v * d.K + k0);
#pragma unroll
    for (int j = 0; j < 8; ++j) { v4u o; o.x = cvtpk(w[8 * j], w[8 * j + 1]); o.y = cvtpk(w[8 * j + 2], w[8 * j + 3]); o.z = cvtpk(w[8 * j + 4], w[8 * j + 5]); o.w = cvtpk(w[8 * j + 6], w[8 * j + 7]); dst[j] = o; }
}

namespace att {
constexpr int KP = 128, HEAD_BYTES = 2 * 64 * KP, BUF_BYTES = 4 * HEAD_BYTES, GK_OFF = 2 * BUF_BYTES, GQ_OFF = GK_OFF + 2048, FLAG_OFF = GQ_OFF + 1024, ATT_LDS_END = FLAG_OFF + 64;
#define MFMA32(a, b, c) __builtin_amdgcn_mfma_f32_32x32x16_bf16((a), (b), (c), 0, 0, 0)
__device__ __forceinline__ void swap_halves(float v, float& lo, float& hi_) { auto rr = __builtin_amdgcn_permlane32_swap(__float_as_uint(v), __float_as_uint(v), false, false); lo = __uint_as_float(rr[0]); hi_ = __uint_as_float(rr[1]); }

__device__ __forceinline__ void dma_tile(const bf16* Kg, const bf16* Vg, int hg, int j, LAS unsigned char* buf, int wid, int lane) {
    const int kv = 8 * wid + (lane >> 3), ch = (lane & 7) ^ ((lane >> 3) & 7);
    const bf16* kp = Kg + (size_t)(64 * j + kv) * D + hg * 256 + ch * 8; const bf16* vp = Vg + (size_t)(64 * j + kv) * D + hg * 256 + ch * 8;
#pragma unroll
    for (int hl = 0; hl < 4; ++hl) {
        __builtin_amdgcn_global_load_lds((const unsigned*)(kp + hl * 64), (LAS unsigned*)(buf + hl * HEAD_BYTES + wid * 1024), 16, 0, 0);
        __builtin_amdgcn_global_load_lds((const unsigned*)(vp + hl * 64), (LAS unsigned*)(buf + hl * HEAD_BYTES + 64 * KP + wid * 1024), 16, 0, 0); }
}
#define DMA_WAIT() asm volatile("s_waitcnt vmcnt(0)" ::: "memory")
typedef short v4i16_t __attribute__((ext_vector_type(4)));
__device__ __forceinline__ s16x4 vtr(const LAS unsigned char* p) { return __builtin_bit_cast(s16x4, __builtin_amdgcn_ds_read_tr16_b64_v4i16((LAS v4i16_t*)p)); }
__device__ __forceinline__ void qk_tile(f32x16& S0, f32x16& S1, const LAS unsigned char* hb, const bf16x8 (&qf)[4], int r32, int hi) {
    const LAS unsigned char* kb = hb + r32 * KP; const int sw = r32 & 7;
#pragma unroll
    for (int d0 = 0; d0 < 4; ++d0) { const int off = ((2 * d0 + hi) ^ sw) << 4; const bf16x8 a0 = *(const LAS bf16x8*)(kb + off), a1 = *(const LAS bf16x8*)(kb + 32 * KP + off);
        S0 = MFMA32(a0, qf[d0], S0); S1 = MFMA32(a1, qf[d0], S1); }
}
__device__ __forceinline__ void pv_tile(f32x16& o0, f32x16& o1, const LAS unsigned char* hb, const float (&pw)[32], int lane) {
    const int sw = 4 * (lane >> 5) + ((lane & 15) >> 2), c0 = 2 * ((lane >> 4) & 1) + ((lane & 3) >> 1);
    const LAS unsigned char* vb = hb + 64 * KP + sw * KP + (lane & 1) * 8; const int of0 = (c0 ^ sw) << 4, of1 = ((c0 + 4) ^ sw) << 4;
#pragma unroll
    for (int p = 0; p < 2; ++p)
#pragma unroll
        for (int s = 0; s < 2; ++s) { const int o = p * 16 + 8 * s;
            v4u pk; pk.x = cvtpk(pw[o], pw[o + 1]); pk.y = cvtpk(pw[o + 2], pw[o + 3]); pk.z = cvtpk(pw[o + 4], pw[o + 5]); pk.w = cvtpk(pw[o + 6], pw[o + 7]);
            const bf16x8 pb = __builtin_bit_cast(bf16x8, pk);
            const int ro = (32 * p + 16 * s) * KP;
            const s16x4 l0 = vtr(vb + ro + of0), h0 = vtr(vb + ro + 8 * KP + of0), l1 = vtr(vb + ro + of1), h1 = vtr(vb + ro + 8 * KP + of1);
            const bf16x8 a0 = __builtin_shufflevector(l0, h0, 0, 1, 2, 3, 4, 5, 6, 7), a1 = __builtin_shufflevector(l1, h1, 0, 1, 2, 3, 4, 5, 6, 7);
            o0 = MFMA32(a0, pb, o0); o1 = MFMA32(a1, pb, o1); }
}
__device__ __forceinline__ void store_o(bf16* Og, int t0w, int h, const f32x16& o0, const f32x16& o1, float sc, int lane, LAS unsigned char* og) {
    const int r32 = lane & 31, hi = lane >> 5;
    LAS unsigned char* wp = og + r32 * 144 + 8 * hi;
#pragma unroll
    for (int g = 0; g < 4; ++g) { v2u w0, w1; w0.x = cvtpk(o0[4 * g] * sc, o0[4 * g + 1] * sc); w0.y = cvtpk(o0[4 * g + 2] * sc, o0[4 * g + 3] * sc);
        w1.x = cvtpk(o1[4 * g] * sc, o1[4 * g + 1] * sc); w1.y = cvtpk(o1[4 * g + 2] * sc, o1[4 * g + 3] * sc);
        *(LAS v2u*)(wp + 16 * g) = w0; *(LAS v2u*)(wp + 64 + 16 * g) = w1; }
    const int row = lane >> 3, ch = lane & 7; bf16* op = Og + (size_t)(t0w + row) * D + h * DH + ch * 8;
#pragma unroll
    for (int it = 0; it < 4; ++it) { const v4u v = *(const LAS v4u*)(og + (8 * it + row) * 144 + ch * 16); *(v4u*)(op + (size_t)(8 * it) * D) = v; }
}
__device__ __forceinline__ float suffix_scan_excl(float v, int lane, float& total) {
    float inc = v;
#pragma unroll
    for (int off = 1; off < 64; off <<= 1) { const float t = __shfl_down(inc, off); if (lane + off < 64) inc += t; }
    total = __shfl(inc, 0); return inc - v;
}

template <bool FOX, bool CONV> __device__ __forceinline__ void attn_unit(int hg, int qb, const bf16* Qg, const bf16* Kg, const bf16* Vg, bf16* Og, const float* LS2, const float* TTp, float bound2, LAS unsigned char* lds,
                                                                        bool has_cv, const TrDesc& cvd, float (&cvw)[64]) {
    int tid_ = threadIdx.x; asm volatile("" : "+v"(tid_));
    const int tid = tid_, lane = tid & 63, r32 = lane & 31, hi = lane >> 5, wid = __builtin_amdgcn_readfirstlane(tid >> 6);
    const int hl = wid >> 1, h = hg * 4 + hl, t0w = qb * 64 + 32 * (wid & 1), tq = t0w + r32, jmax = qb;
    volatile LAS int* flags = (volatile LAS int*)(lds + FLAG_OFF);
    LAS float* GK = (LAS float*)(lds + GK_OFF); LAS float* GQ = (LAS float*)(lds + GQ_OFF);
    const float* glh = LS2 + (size_t)(hg * 4 + (wid & 3)) * M; const float* tth = TTp + (hg * 4 + (wid & 3)) * 256;
    bf16x8 qf[4];
#pragma unroll
    for (int d0 = 0; d0 < 4; ++d0) qf[d0] = *(const bf16x8*)(Qg + (size_t)tq * D + h * DH + d0 * 16 + hi * 8);
    float gnext = 0.f, tnext = 0.f, cgk = 0.f, ex0 = 0.f;
    if (FOX && wid < 4) { ex0 = glh[64 * jmax + lane]; cgk = tth[jmax]; }
    f32x16 o0 = {}, o1 = {}; float carry = 1.f, mrun = -INFINITY, lsum = 0.f; bool wdone = false;
    __syncthreads();
    dma_tile(Kg, Vg, hg, jmax, lds, wid, lane);
    if (tid < 16) flags[tid] = 0;
    if (FOX && wid < 4) { GK[wid * 64 + lane] = ex0; GQ[wid * 64 + lane] = ex0; }
    if (CONV && has_cv) { tr_issue(cvd, lane, cvw); asm volatile("s_waitcnt vmcnt(63) lgkmcnt(0)" ::: "memory"); }
    else asm volatile("s_waitcnt vmcnt(0) lgkmcnt(0)" ::: "memory");
    __builtin_amdgcn_s_barrier(); asm volatile("" ::: "memory");
    float gq = 0.f, gq0 = 0.f; if (FOX) { gq = GQ[hl * 64 + (wid & 1) * 32 + r32]; gq0 = GQ[hl * 64 + (wid & 1) * 32]; }
    for (int j = jmax, it = 0;; --j, ++it) {
        const int b = it & 1; const LAS unsigned char* hb = lds + b * BUF_BYTES + hl * HEAD_BYTES; const LAS float* gkb = GK + b * 256 + hl * 64;
        if (it > 0) { int nd = 0;
#pragma unroll
            for (int w = 0; w < 8; ++w) nd += flags[((it - 1) & 1) * 8 + w];
            if (nd == 8) break; }
        const bool have_next = j > 0;
        if (have_next) { dma_tile(Kg, Vg, hg, j - 1, lds + (b ^ 1) * BUF_BYTES, wid, lane); if (FOX && wid < 4) { gnext = glh[64 * (j - 1) + lane]; tnext = tth[j - 1]; } }
        if (!wdone) {
            const bool need_mask = (j == jmax);
            if (!FOX) {
                f32x16 S0 = {}, S1 = {};
                qk_tile(S0, S1, hb, qf, r32, hi);
                float be[32], om[32];
#pragma unroll
                for (int p = 0; p < 2; ++p)
#pragma unroll
                    for (int i = 0; i < 16; ++i) { const float z = fmaxf(p ? S1[i] : S0[i], -100.f);
                        const float t = ex2(-z), bt = __builtin_amdgcn_rcpf(1.f + t);
                        be[p * 16 + i] = bt; om[p * 16 + i] = t * bt; }
                if (need_mask) {
#pragma unroll
                    for (int p = 0; p < 2; ++p)
#pragma unroll
                        for (int i = 0; i < 16; ++i) { const int kv = 64 * j + 32 * p + (i & 3) + 8 * (i >> 2) + 4 * hi; const bool ok = kv < tq;
                            be[p * 16 + i] = ok ? be[p * 16 + i] : 0.f; om[p * 16 + i] = ok ? om[p * 16 + i] : 1.f; } }
                float base = carry;
#pragma unroll
                for (int p = 1; p >= 0; --p)
#pragma unroll
                    for (int g = 3; g >= 0; --g) { const int o = p * 16 + 4 * g;
                        const float q2 = om[o + 3], q1 = q2 * om[o + 2], q0 = q1 * om[o + 1], G = q0 * om[o];
                        float Glo, Ghi; swap_halves(G, Glo, Ghi);
                        const float bl = base * (hi ? 1.f : Ghi);
                        be[o + 3] *= bl; be[o + 2] *= bl * q2; be[o + 1] *= bl * q1; be[o] *= bl * q0;
                        base *= Glo * Ghi; }
                carry = base;
                pv_tile(o0, o1, hb, be, lane);
                wdone = __all(carry < SB_EPS);
            } else {
                if (__all(gkb[63] - gq + bound2 - mrun < -THR2)) wdone = true;
                else {
                    f32x16 S0 = {}, S1 = {};
                    qk_tile(S0, S1, hb, qf, r32, hi);
                    float x[32]; float tmax = -INFINITY;
#pragma unroll
                    for (int p = 0; p < 2; ++p)
#pragma unroll
                        for (int g = 0; g < 4; ++g) { const f32x4 gk4 = *(const LAS f32x4*)(gkb + 32 * p + 8 * g + 4 * hi);
#pragma unroll
                            for (int e = 0; e < 4; ++e) { const int i = 4 * g + e; const float z = p ? S1[i] : S0[i];
                                const int kv = 64 * j + 32 * p + 8 * g + 4 * hi + e;
                                float v = z + (gk4[e] - gq);
                                if (need_mask && kv > tq) v = -INFINITY;
                                x[p * 16 + i] = v; tmax = fmaxf(tmax, v); } }
                    float tl, th; swap_halves(tmax, tl, th); tmax = fmaxf(tl, th);
                    const float mnew = fmaxf(mrun, tmax), alpha = ex2(mrun - mnew); mrun = mnew;
                    float ps = 0.f;
#pragma unroll
                    for (int i = 0; i < 32; ++i) { x[i] = ex2(x[i] - mnew); ps += x[i]; }
                    lsum = lsum * alpha + ps;
                    if (!__all(alpha == 1.0f)) {
#pragma unroll
                        for (int i = 0; i < 16; ++i) { o0[i] *= alpha; o1[i] *= alpha; } }
                    pv_tile(o0, o1, hb, x, lane);
                }
            }
        }
        if (lane == 0) flags[b * 8 + wid] = wdone ? 1 : 0;
        if (have_next && FOX && wid < 4) { GK[(b ^ 1) * 256 + wid * 64 + lane] = cgk + gnext; cgk += tnext; }
        DMA_WAIT(); __syncthreads();
        if (!have_next) break;
    }
    float sc = 1.f;
    if (FOX) { float ll, lh; swap_halves(lsum, ll, lh); sc = __builtin_amdgcn_rcpf(ll + lh); }
    store_o(Og, t0w, h, o0, o1, sc, lane, lds + wid * 4608);
}
#undef MFMA32
}

struct Frame { LAS unsigned char* lds; int tid, lane, wave, vcu, G; };
__device__ __forceinline__ float wave_sum(float v) {
#pragma unroll
    for (int o = 1; o < 64; o <<= 1) v += __shfl_xor(v, o);
    return v;
}
__device__ __forceinline__ float wave_max(float v) {
#pragma unroll
    for (int o = 1; o < 64; o <<= 1) v = fmaxf(v, __shfl_xor(v, o));
    return v;
}
template <int MAP> __device__ __forceinline__ void tr_item(const float* W, int K, int ldw, int csrc0, int nblk, const float* gain, bf16* WT, int item, int lane) {
    const int kb = item / nblk, nb = item % nblk, k0 = 64 * kb, n = 64 * nb + lane;
    int v;
    if (MAP == 0) v = n;
    else if (MAP == 1) { const int head = n >> 6, c = n & 63; v = 256 * (head >> 2) + 128 * (c >> 5) + 32 * (head & 3) + (c & 31); }
    else { const int isu = n >= FF, c = isu ? n - FF : n; v = 256 * (c >> 7) + 128 * isu + (c & 127); }
    const float* src = W + (size_t)k0 * ldw + csrc0 + n;
    float w[64];
#pragma unroll
    for (int i = 0; i < 64; ++i) w[i] = src[(size_t)i * ldw];
    if (gain) {
#pragma unroll
        for (int i = 0; i < 64; ++i) w[i] *= gain[k0 + i]; }
    v4u* dst = (v4u*)(WT + (size_t)v * K + k0);
#pragma unroll
    for (int j = 0; j < 8; ++j) { v4u o; o.x = cvtpk(w[8 * j], w[8 * j + 1]); o.y = cvtpk(w[8 * j + 2], w[8 * j + 3]); o.z = cvtpk(w[8 * j + 4], w[8 * j + 5]); o.w = cvtpk(w[8 * j + 6], w[8 * j + 7]); dst[j] = o; }
}


struct Args { const float* in[18]; float* out; unsigned char* ws; };
typedef const __attribute__((address_space(4))) Args* ArgsP;
__device__ __forceinline__ ArgsP argp() { ArgsP p = (ArgsP)__builtin_amdgcn_kernarg_segment_ptr(); asm volatile("" : "+s"(p)); return p; }
#define WSP(T, off) ((T*)(A->ws + (off)))
enum { IN_X = 0, IN_P, IN_ATTN_G, IN_SB_WQKV, IN_SB_WO, IN_SHARED_G, IN_WKVF, IN_BF, IN_KNORM_G, IN_FOX_WQ, IN_QNORM_G, IN_FOX_WO, IN_FFN_G, IN_WGU, IN_WD, IN_PLE_G, IN_WGATE, IN_WPROJ };

__device__ __forceinline__ void convert_p(const Frame& F, const float* psrc, bf16* pdst) {
    const int gw = F.vcu * NWAVES + F.wave, NGW = F.G * NWAVES; const f32x4* ps = (const f32x4*)psrc; v2u* pd = (v2u*)pdst;
    for (int i = gw * 64 + F.lane; i < M * PLE / 4; i += NGW * 64) { const f32x4 v = ps[i]; v2u w; w.x = pk2(v.x, v.y); w.y = pk2(v.z, v.w); pd[i] = w; }
}

template <int PART> __device__ __forceinline__ void prologue(const Frame& F) {
    ArgsP A = argp();
    const int gw = F.wave * F.G + F.vcu, NGW = F.G * NWAVES;
    constexpr int I0 = 16 * 48, I1 = 256, I2 = 256, I3 = 256, I4 = 256, I5 = 256, I6 = 16 * 88, I7 = 44 * 16, I8 = 256, I9 = 4 * 16;
    constexpr int NITEMS = I0 + I1 + I2 + I3 + I4 + I5 + 2 * I6 + 2 * I7 + 2 * I8 + 2 * I9;
    constexpr int N1 = I1 + I6 + I7 + I8 + I9, N2 = I2 + I3 + I4 + I5 + I6 + I7 + I8 + I9; static_assert(I0 + N1 + N2 == NITEMS, "item count");
    for (int it = gw; it < (PART == 0 ? I0 : PART == 1 ? N1 : N2); it += NGW) {
        int r = it;
        if (PART == 0) { tr_item<0>(A->in[IN_SB_WQKV], D, 3 * D, 0, 48, A->in[IN_ATTN_G], WSP(bf16, WS_WQKV0), r, F.lane); continue; }
        if (PART == 1) { if (r < I1) { tr_item<0>(A->in[IN_SB_WO], D, D, 0, 16, nullptr, WSP(bf16, WS_WO0), r, F.lane); continue; } r -= I1; }
        else {
            if (r < I2) { tr_item<1>(A->in[IN_WKVF], D, 2 * D + NH, 0, 16, A->in[IN_SHARED_G], WSP(bf16, WS_WKVQ1), r, F.lane); continue; } r -= I2;
            if (r < I3) { tr_item<1>(A->in[IN_WKVF], D, 2 * D + NH, D, 16, A->in[IN_SHARED_G], WSP(bf16, WS_WKVQ1) + (size_t)D * D, r, F.lane); continue; } r -= I3;
            if (r < I4) { tr_item<1>(A->in[IN_FOX_WQ], D, D, 0, 16, A->in[IN_ATTN_G] + D, WSP(bf16, WS_WKVQ1) + (size_t)2 * D * D, r, F.lane); continue; } r -= I4;
            if (r < I5) { tr_item<0>(A->in[IN_FOX_WO], D, D, 0, 16, nullptr, WSP(bf16, WS_WO1), r, F.lane); continue; } r -= I5; }
        constexpr int l = PART == 1 ? 0 : 1;
        if (r < I6) { tr_item<2>(A->in[IN_WGU] + (size_t)l * D * 2 * FF, D, 2 * FF, 0, 88, A->in[IN_FFN_G] + l * D, WSP(bf16, WS_WGU) + (size_t)l * 2 * FF * D, r, F.lane); continue; } r -= I6;
        if (r < I7) { tr_item<0>(A->in[IN_WD] + (size_t)l * FF * D, FF, D, 0, 16, nullptr, WSP(bf16, WS_WD) + (size_t)l * D * FF, r, F.lane); continue; } r -= I7;
        if (r < I8) { tr_item<0>(A->in[IN_WGATE] + (size_t)l * D * D, D, D, 0, 16, A->in[IN_PLE_G] + l * D, WSP(bf16, WS_WG) + (size_t)l * D * D, r, F.lane); continue; } r -= I8;
        tr_item<0>(A->in[IN_WPROJ] + (size_t)l * PLE * D, PLE, D, 0, 16, nullptr, WSP(bf16, WS_WP) + (size_t)l * D * PLE, r, F.lane);
    }
    if (PART == 2) { const float* wk = A->in[IN_WKVF]; const float* sg = A->in[IN_SHARED_G]; bf16* WF = WSP(bf16, WS_WF);
      for (int i = gw * 64 + F.lane; i < NH * D; i += NGW * 64) { const int n = i >> 10, k = i & 1023; WF[i] = (bf16)f2bf(wk[(size_t)k * (2 * D + NH) + 2 * D + n] * sg[k]); } }
    if (PART == 0) { const float* x = A->in[IN_X]; bf16* HBA = WSP(bf16, WS_HBA); float* SSQ = WSP(float, WS_SSQ);
      for (int m0 = gw * 4; m0 < M; m0 += NGW * 4) {
        f32x4 v[4][4];
#pragma unroll
        for (int r = 0; r < 4; ++r) { const f32x4* xr = (const f32x4*)(x + (size_t)(m0 + r) * D) + F.lane;
#pragma unroll
            for (int j = 0; j < 4; ++j) v[r][j] = xr[64 * j]; }
#pragma unroll
        for (int r = 0; r < 4; ++r) { float s = 0.f;
#pragma unroll
            for (int j = 0; j < 4; ++j) s += (v[r][j].x * v[r][j].x + v[r][j].y * v[r][j].y) + (v[r][j].z * v[r][j].z + v[r][j].w * v[r][j].w);
            s = wave_sum(s);
            v2u* o8 = (v2u*)(HBA + (size_t)(m0 + r) * D) + F.lane;
#pragma unroll
            for (int j = 0; j < 4; ++j) { v2u w; w.x = cvtpk(v[r][j].x, v[r][j].y); w.y = cvtpk(v[r][j].z, v[r][j].w); o8[64 * j] = w; }
            if (F.lane == 0) *(f32x4*)(SSQ + (size_t)(m0 + r) * 4) = (f32x4){s, 0.f, 0.f, 0.f}; }
      } }
}

#ifdef TSTAMP_A
#define TSTAMP(i) do { if (blockIdx.x == 0 && F.tid == 0) { ArgsP A_ = argp(); ((unsigned long long*)(A_->ws + 49152))[(i)] = __builtin_amdgcn_s_memrealtime(); } } while (0)
#else
#define TSTAMP(i) do {} while (0)
#endif

constexpr int CV_I1 = 256, CV_I6 = 16 * 88, CV_I7 = 44 * 16, CV_I8 = 256, CV_I9 = 4 * 16, CV_N1 = CV_I1 + CV_I6 + CV_I7 + CV_I8 + CV_I9, CV_N2 = 4 * 256 + CV_I6 + CV_I7 + CV_I8 + CV_I9, CV_N = CV_N1 + CV_N2;
__device__ __forceinline__ TrDesc cv_decode(int r) {
    ArgsP A = argp(); TrDesc d; d.gain = nullptr; d.K = D; d.ldw = D; d.csrc0 = 0; d.nblk = 16; d.map = 0;
    int l = 0;
    if (r >= CV_N1) { r -= CV_N1; l = 1;
        if (r < 256) { d.W = A->in[IN_WKVF]; d.ldw = 2 * D + NH; d.gain = A->in[IN_SHARED_G]; d.WT = WSP(bf16, WS_WKVQ1); d.map = 1; d.item = r; return d; } r -= 256;
        if (r < 256) { d.W = A->in[IN_WKVF]; d.ldw = 2 * D + NH; d.csrc0 = D; d.gain = A->in[IN_SHARED_G]; d.WT = WSP(bf16, WS_WKVQ1) + (size_t)D * D; d.map = 1; d.item = r; return d; } r -= 256;
        if (r < 256) { d.W = A->in[IN_FOX_WQ]; d.gain = A->in[IN_ATTN_G] + D; d.WT = WSP(bf16, WS_WKVQ1) + (size_t)2 * D * D; d.map = 1; d.item = r; return d; } r -= 256;
        if (r < 256) { d.W = A->in[IN_FOX_WO]; d.WT = WSP(bf16, WS_WO1); d.item = r; return d; } r -= 256;
    } else { if (r < CV_I1) { d.W = A->in[IN_SB_WO]; d.WT = WSP(bf16, WS_WO0); d.item = r; return d; } r -= CV_I1; }
    if (r < CV_I6) { d.W = A->in[IN_WGU] + (size_t)l * D * 2 * FF; d.ldw = 2 * FF; d.nblk = 88; d.gain = A->in[IN_FFN_G] + l * D; d.WT = WSP(bf16, WS_WGU) + (size_t)l * 2 * FF * D; d.map = 2; d.item = r; return d; } r -= CV_I6;
    if (r < CV_I7) { d.W = A->in[IN_WD] + (size_t)l * FF * D; d.K = FF; d.WT = WSP(bf16, WS_WD) + (size_t)l * D * FF; d.item = r; return d; } r -= CV_I7;
    if (r < CV_I8) { d.W = A->in[IN_WGATE] + (size_t)l * D * D; d.gain = A->in[IN_PLE_G] + l * D; d.WT = WSP(bf16, WS_WG) + (size_t)l * D * D; d.item = r; return d; } r -= CV_I8;
    d.W = A->in[IN_WPROJ] + (size_t)l * PLE * D; d.K = PLE; d.WT = WSP(bf16, WS_WP) + (size_t)l * D * PLE; d.item = r; return d;
}

template <int L> __device__ __forceinline__ void layer(const Frame& F, const XcdBarrier& bar) {
    constexpr size_t SSQ_A = WS_SSQ + (size_t)(3 * L) * M * 16, SSQ_B = WS_SSQ + (size_t)(3 * L + 1) * M * 16, SSQ_C = WS_SSQ + (size_t)(3 * L + 2) * M * 16, SSQ_D = WS_SSQ + (size_t)(3 * L + 3) * M * 16;
    if (L == 0) {
        ArgsP A = argp();
        pg8::Gemm g{WSP(bf16, WS_HBA), WSP(bf16, WS_WQKV0), M, 3 * D, D}; pg8::StaticOrder S; S.init(M, 3 * D, F.G, (int)blockIdx.x);
        pg8::EpiQKV0 E{WSP(bf16, WS_Q), (size_t)M * D, WSP(float, SSQ_A), QSCALE};
        pg8::gemm_phase<pg8::EpiQKV0, pg8::StaticOrder, true, true>(F.lds, g, S, E);
    } else {
        { ArgsP A = argp(); const bf16* HBB = WSP(bf16, WS_HBB); const bf16* WF = WSP(bf16, WS_WF); float* GL = WSP(float, WS_LS2); float* TT = WSP(float, WS_TT); const float* ssq = WSP(float, SSQ_A); const float* b_f = A->in[IN_BF];
          LAS float* T = (LAS float*)F.lds;
          for (int rb = blockIdx.x; rb < M / 64; rb += F.G) {
            if (F.wave < 4) { const int fr = F.lane & 15, fq = F.lane >> 4, row0 = rb * 64 + F.wave * 16;
                const bf16* ap = HBB + (size_t)(row0 + fr) * D + 8 * fq; const bf16* bp = WF + (size_t)fr * D + 8 * fq;
                f32x4 acc = {0.f, 0.f, 0.f, 0.f};
#pragma unroll 16
                for (int kk = 0; kk < 32; ++kk) { const bf16x8 a = *(const bf16x8*)(ap + kk * 32), b = *(const bf16x8*)(bp + kk * 32); acc = __builtin_amdgcn_mfma_f32_16x16x32_bf16(a, b, acc, 0, 0, 0); }
                const float bias = b_f[fr]; f32x4 o;
#pragma unroll
                for (int i = 0; i < 4; ++i) { const float f2 = (acc[i] * pg8::row_rinv(ssq, row0 + 4 * fq + i) + bias) * LOG2E_F;
                    o[i] = -(fmaxf(-f2, 0.f) + lg2(1.f + ex2(-fabsf(f2)))); }
                *(LAS f32x4*)(T + fr * 64 + F.wave * 16 + 4 * fq) = o; }
            __syncthreads();
#pragma unroll
            for (int hh = 0; hh < 2; ++hh) { const int hd = 2 * F.wave + hh; float tot; const float ex = att::suffix_scan_excl(T[hd * 64 + F.lane], F.lane, tot);
                GL[(size_t)hd * M + rb * 64 + F.lane] = ex; if (F.lane == 0) TT[hd * 256 + rb] = tot; }
            __syncthreads();
          } }
        ArgsP A = argp();
        pg8::Gemm g{WSP(bf16, WS_HBB), WSP(bf16, WS_WKVQ1), M, 3 * D, D}; pg8::StaticOrder S; S.init(M, 3 * D, F.G, (int)blockIdx.x);
        pg8::EpiKVQ1 E{WSP(bf16, WS_Q), (size_t)M * D, WSP(float, SSQ_A), A->in[IN_KNORM_G], A->in[IN_QNORM_G], QSCALE};
        pg8::gemm_phase<pg8::EpiKVQ1, pg8::StaticOrder, true, true>(F.lds, g, S, E);
    }
    xcd_barrier(bar); TSTAMP(2 + 6 * L);
    {
        ArgsP A = argp();
        float bound2 = 0.f;
        if (L == 1) { const float mq = wave_max(fabsf(A->in[IN_QNORM_G][F.lane])), mk = wave_max(fabsf(A->in[IN_KNORM_G][F.lane])); bound2 = 1.02f * 8.0f * LOG2E_F * mq * mk; }
        bf16* QB = WSP(bf16, WS_Q); const bf16* KB = WSP(bf16, WS_K); const bf16* VB = WSP(bf16, WS_V); const float* LS2 = WSP(float, WS_LS2); const float* TT = WSP(float, WS_TT);
#ifdef REP_ATT
        if (L == REP_ATT - 1) { bf16* DUMMY = WSP(bf16, WS_PROJ);
          for (int un = F.vcu; un < 4 * (M / 64); un += F.G) { const int hg = un >> 8, qb = un & 255;
            { TrDesc d0; float w0[64]; if (L == 0) att::attn_unit<false, false>(hg, qb, QB, KB, VB, DUMMY, LS2, TT, 0.f, F.lds, false, d0, w0);
            else att::attn_unit<true, false>(hg, qb, QB, KB, VB, DUMMY, LS2, TT, bound2, F.lds, false, d0, w0); } }
          __syncthreads(); xcd_barrier(bar); }
#endif
        if (!(blockIdx.x & 1)) convert_p(F, A->in[IN_P] + (size_t)L * M * PLE, WSP(bf16, L == 0 ? WS_PBUF0 : WS_PBUF1));
        constexpr int CV_SPLIT = CV_N1 + 768;
        if (L == 0) {
            int cit = F.wave * F.G + F.vcu; const int NGW = F.G * NWAVES;
            for (int un = F.vcu; un < 4 * (M / 64); un += F.G) { const int hg = un >> 8, qb = un & 255;
                const bool has = cit < CV_SPLIT; TrDesc d; float w[64];
                if (has) d = cv_decode(cit);
                att::attn_unit<false, true>(hg, qb, QB, KB, VB, QB, LS2, TT, 0.f, F.lds, has, d, w);
                if (has) tr_finish(d, F.lane, w);
                cit += NGW; }
            for (; cit < CV_SPLIT; cit += NGW) { TrDesc d = cv_decode(cit); float w[64]; tr_issue(d, F.lane, w); tr_finish(d, F.lane, w); }
            { const float* wk = A->in[IN_WKVF]; const float* sg = A->in[IN_SHARED_G]; bf16* WF = WSP(bf16, WS_WF); const int gw = F.wave * F.G + F.vcu;
              for (int i = gw * 64 + F.lane; i < NH * D; i += NGW * 64) { const int n = i >> 10, k = i & 1023; WF[i] = (bf16)f2bf(wk[(size_t)k * (2 * D + NH) + 2 * D + n] * sg[k]); } }
        } else {
            int cit = CV_SPLIT + F.wave * F.G + F.vcu; const int NGW = F.G * NWAVES;
            for (int un = F.vcu; un < 4 * (M / 64); un += F.G) { const int hg = un >> 8, qb = un & 255;
                const bool has = cit < CV_N; TrDesc d; float w[64];
                if (has) d = cv_decode(cit);
                att::attn_unit<true, true>(hg, qb, QB, KB, VB, QB, LS2, TT, bound2, F.lds, has, d, w);
                if (has) tr_finish(d, F.lane, w);
                cit += NGW; }
            for (; cit < CV_N; cit += NGW) { TrDesc d = cv_decode(cit); float w[64]; tr_issue(d, F.lane, w); tr_finish(d, F.lane, w); }
        }
        if (blockIdx.x & 1) convert_p(F, A->in[IN_P] + (size_t)L * M * PLE, WSP(bf16, L == 0 ? WS_PBUF0 : WS_PBUF1));
        __syncthreads();
    }
    xcd_barrier(bar); TSTAMP(3 + 6 * L);
#ifdef REP_WO
    for (int rep_ = 0; rep_ < 1 + (L == 0 ? REP_WO : 0); ++rep_) { if (rep_) xcd_barrier(bar);
#else
    {
#endif
    for (int idx = blockIdx.x; idx < 256; idx += F.G) {
        ArgsP A = argp();
        pg8::StaticOrder S0; S0.init(M, D, 256, idx); pg8::OneUnit S; S0.next(0, S.u);
        pg8::Gemm g{WSP(bf16, WS_Q), WSP(bf16, L == 0 ? WS_WO0 : WS_WO1), M, D, D};
        pg8::EpiRes<false> E{L == 0 ? (const void*)WSP(bf16, WS_HBA) : (const void*)WSP(bf16, WS_HBB), WSP(bf16, WS_HBA), WSP(float, SSQ_B)};
        pg8::gemm_phase<pg8::EpiRes<false>, pg8::OneUnit, false, true>(F.lds, g, S, E);
    }
    }
    xcd_barrier(bar); TSTAMP(4 + 6 * L);
#ifdef REP_GU
    for (int rep_ = 0; rep_ < 1 + (L == 0 ? REP_GU : 0); ++rep_) { if (rep_) xcd_barrier(bar);
#else
    {
#endif
    {
        ArgsP A = argp();
        pg8::Gemm g{WSP(bf16, WS_HBA), WSP(bf16, WS_WGU) + (size_t)L * 2 * FF * D, M, 2 * FF, D}; pg8::StaticOrder S; S.init(M, 2 * FF, F.G, (int)blockIdx.x);
        pg8::EpiGU E{WSP(bf16, WS_ACT), WSP(float, SSQ_B)};
        pg8::gemm_phase<pg8::EpiGU, pg8::StaticOrder, true, true>(F.lds, g, S, E);
    }
    { const int rem = ((M / 256) * (2 * FF / 256)) % F.G, nlight = F.G - rem, lb = (int)blockIdx.x - rem;
      if (lb >= 0) for (int pu = lb; pu < 256; pu += nlight) {
        ArgsP A = argp(); pg8::StaticOrder S0; S0.init(M, D, 256, pu); pg8::OneUnit S; S0.next(0, S.u);
        pg8::Gemm g{WSP(bf16, L == 0 ? WS_PBUF0 : WS_PBUF1), WSP(bf16, WS_WP) + (size_t)L * D * PLE, M, D, PLE}; pg8::EpiProj E{WSP(bf16, WS_PROJ)};
        pg8::gemm_phase<pg8::EpiProj, pg8::OneUnit, false, true>(F.lds, g, S, E); } }
    }
    xcd_barrier(bar); TSTAMP(5 + 6 * L);
    for (int idx = blockIdx.x; idx < 256; idx += F.G) {
        ArgsP A = argp();
        pg8::StaticOrder S0; S0.init(M, D, 256, idx); pg8::OneUnit S; S0.next(0, S.u);
        pg8::Gemm g{WSP(bf16, WS_ACT), WSP(bf16, WS_WD) + (size_t)L * D * FF, M, D, FF};
        pg8::EpiRes<false> E{(const void*)WSP(bf16, WS_HBA), WSP(bf16, WS_HBA), WSP(float, SSQ_C)};
        pg8::gemm_phase<pg8::EpiRes<false>, pg8::OneUnit, false, true>(F.lds, g, S, E);
    }
    xcd_barrier(bar); TSTAMP(6 + 6 * L);
#ifdef REP_PLE
    for (int rep_ = 0; rep_ < 1 + (L == 0 ? REP_PLE : 0); ++rep_) { if (rep_) xcd_barrier(bar);
#else
    {
#endif
    for (int idx = blockIdx.x; idx < 256; idx += F.G) {
        pg8::StaticOrder S0; S0.init(M, D, 256, idx); pg8::OneUnit S; S0.next(0, S.u);
        { ArgsP A = argp(); pg8::Gemm g{WSP(bf16, WS_HBA), WSP(bf16, WS_WG) + (size_t)L * D * D, M, D, D};
          pg8::EpiPle E{WSP(float, SSQ_C), WSP(bf16, WS_HBA), WSP(bf16, WS_PROJ), L == 0 ? WSP(bf16, WS_HBB) : (bf16*)nullptr, L == 0 ? (float*)nullptr : A->out, L == 0 ? WSP(float, SSQ_D) : (float*)nullptr};
          pg8::gemm_phase<pg8::EpiPle, pg8::OneUnit, false, true>(F.lds, g, S, E); }
    }
    }
    if (L == 0) { xcd_barrier(bar); TSTAMP(7);
    }
#ifdef TSTAMP_A
    if (L == 1) { xcd_barrier(bar); TSTAMP(13); xcd_barrier(bar);
        ArgsP A = argp(); const unsigned long long* st = (const unsigned long long*)(A->ws + 49152);
        const float d = (float)(st[TSTAMP_A] - st[TSTAMP_A - 1]); const float dl = 0.05f * sqrtf(d * 1e-4f);
        for (int i = blockIdx.x * 512 + F.tid; i < 65536; i += F.G * 512) A->out[4096 + i] += (i & 1) ? dl : -dl; }
#endif
}

__global__ void __launch_bounds__(NWAVES * 64, 2) mega_fwd(Args args) {
    extern __shared__ __attribute__((aligned(16))) unsigned char lds_raw[];
    Frame F;
    F.lds = (LAS unsigned char*)lds_raw;
    F.tid = threadIdx.x; F.lane = F.tid & 63; F.wave = __builtin_amdgcn_readfirstlane(F.tid >> 6);
    F.G = gridDim.x; { const int bx = blockIdx.x; F.vcu = (F.G % 8 == 0) ? (bx % 8) * (F.G / 8) + bx / 8 : bx; }
    volatile LAS unsigned* MISC = (volatile LAS unsigned*)(F.lds + MISC_OFF);
    for (int u = F.tid; u < (LDS_BYTES - RING_BYTES) / 4; u += NWAVES * 64) ((LAS unsigned*)(F.lds + RING_BYTES))[u] = 0u;
    __syncthreads();
    XcdBarrier bar;
    { ArgsP A = argp(); bar = xcd_barrier_post(WSP(unsigned, WS_CTL) + CW_BAR, MISC + 8); }
    TSTAMP(0);
#ifdef REP_PRO
    for (int rep_ = 0; rep_ < REP_PRO; ++rep_) { prologue<0>(F); xcd_barrier(bar); }
#endif
    prologue<0>(F);
    if (gridDim.y == 0x7fffu) cg::this_grid().sync();
    xcd_barrier(bar); TSTAMP(1);
    layer<0>(F, bar);
    layer<1>(F, bar);
    (void)args;
}

extern "C" void kernel_launch(void* const* d_in, const int* in_sizes, int n_in, void* d_out, int out_size, void* d_ws, size_t ws_size, hipStream_t stream) {
    static int grid = 0;
    if (grid == 0) {
        if (n_in != 18 || in_sizes[0] != M * D || out_size != M * D || ws_size < WS_END) { fprintf(stderr, "kernel_launch: unexpected shapes (n_in %d, in0 %d, out %d, ws %zu); nothing launched\n", n_in, n_in > 0 ? in_sizes[0] : -1, out_size, ws_size); grid = -1; return; }
        int dev = 0, cus = 0, per_cu = 0;
        if (hipGetDevice(&dev) != hipSuccess || hipDeviceGetAttribute(&cus, hipDeviceAttributeMultiprocessorCount, dev) != hipSuccess) { fprintf(stderr, "kernel_launch: device query failed\n"); grid = -1; return; }
        if (hipFuncSetAttribute((const void*)mega_fwd, hipFuncAttributeMaxDynamicSharedMemorySize, LDS_BYTES) != hipSuccess) { fprintf(stderr, "kernel_launch: hipFuncSetAttribute failed\n"); grid = -1; return; }
        if (hipOccupancyMaxActiveBlocksPerMultiprocessor(&per_cu, (const void*)mega_fwd, NWAVES * 64, LDS_BYTES) != hipSuccess || per_cu < 1) { fprintf(stderr, "kernel_launch: occupancy query says %d\n", per_cu); per_cu = 1; }
        (void)hipGetLastError();
        grid = cus * per_cu;
    }
    if (grid < 0) return;
    if (hipMemsetAsync((char*)d_ws + WS_CTL, 0, CTL_ZERO_BYTES, stream) != hipSuccess) { fprintf(stderr, "kernel_launch: memset failed\n"); return; }
    Args a{};
    for (int i = 0; i < 18; ++i) a.in[i] = (const float*)d_in[i];
    a.out = (float*)d_out; a.ws = (unsigned char*)d_ws;
    void* kargs[] = {&a};
    const hipError_t e = hipLaunchCooperativeKernel((const void*)mega_fwd, dim3(grid), dim3(NWAVES * 64), kargs, LDS_BYTES, stream);
    if (e != hipSuccess) fprintf(stderr, "kernel_launch: cooperative launch failed: %s (grid %d)\n", hipGetErrorString(e), grid);
}
```
